# Optimizing an MI355X kernel written in HIP

```python
import math
import jax, jax.numpy as jnp
from jax import lax
import numpy as np

D_MODEL = 1024
BATCH = 4
SEQ = 4096
DEPTH = 2

N_MEM = 256
RMS_EPS = 1e-6
MAX_POS_OFFSET = 1024
MASK_VALUE = -1e30

SSM_GROUPS = 32
SSM_GROUP_CH = 16
SSM_WIDTH = SSM_GROUPS * SSM_GROUP_CH
SSM_STATE = 64

MLA_HEADS = 8
MLA_Q_RANK = 512
MLA_KV_RANK = 256
MLA_NOPE = 64
MLA_ROPE = 32
MLA_V = 64
MLA_WIDTH = MLA_HEADS * MLA_V
ROPE_THETA = 10000.0
Q_BLOCK = 128

HG_HEADS = 4
HG_DK = 128
HG_DV = 128
HG_WIDTH = HG_HEADS * HG_DK
HG_CHUNK = 64

X_HEADS = 4
X_HEAD_DIM = 128
X_WIDTH = X_HEADS * X_HEAD_DIM

D_FF = -(-(8 * D_MODEL) // (3 * 256)) * 256

N_BRANCH = 3
IN_SPLITS = [SSM_WIDTH, MLA_Q_RANK, MLA_KV_RANK, MLA_ROPE,
             HG_HEADS * HG_DK, HG_HEADS * HG_DK, HG_HEADS * HG_DV, HG_HEADS * HG_DV,
             N_BRANCH * D_MODEL]
D_IN = sum(IN_SPLITS)

kernel_name = "hybrid_s5_mla_hgrn2_gated_block"


def rmsnorm(x, g):
    xf = x.astype(jnp.float32)
    y = xf * lax.rsqrt(jnp.mean(xf * xf, axis=-1, keepdims=True) + RMS_EPS)
    return (y * g.astype(jnp.float32)).astype(x.dtype)


def rope_tables(positions):
    half = MLA_ROPE // 2
    inv_freq = ROPE_THETA ** (-jnp.arange(half, dtype=jnp.float32) / half)
    ang = positions.astype(jnp.float32)[..., None] * inv_freq
    return jnp.cos(ang), jnp.sin(ang)


def apply_rope(x, cos, sin):
    xf = x.astype(jnp.float32)
    x1, x2 = jnp.split(xf, 2, axis=-1)
    return jnp.concatenate([x1 * cos - x2 * sin, x2 * cos + x1 * sin], axis=-1).astype(x.dtype)


def s5_mixer(u, lam_re, lam_im, b_re, b_im, c_re, c_im, d_skip, log_step, w_glu):
    bsz, s, _ = u.shape
    uf = u.astype(jnp.float32).reshape(bsz, s, SSM_GROUPS, SSM_GROUP_CH)
    lam = lax.complex(lam_re.astype(jnp.float32), lam_im.astype(jnp.float32))
    step = jnp.exp(log_step.astype(jnp.float32))[:, None]
    lam_bar = jnp.exp(lam * step)
    b_mat = lax.complex(b_re.astype(jnp.float32), b_im.astype(jnp.float32))
    b_bar = ((lam_bar - 1.0) / lam)[..., None] * b_mat
    bu = jnp.einsum('bsgh,gph->bsgp', uf.astype(jnp.complex64), b_bar)
    a = jnp.broadcast_to(lam_bar, bu.shape)

    def combine(left, right):
        a_l, b_l = left
        a_r, b_r = right
        return a_r * a_l, a_r * b_l + b_r

    _, states = lax.associative_scan(combine, (a, bu), axis=1)
    c_mat = lax.complex(c_re.astype(jnp.float32), c_im.astype(jnp.float32))
    y = jnp.real(jnp.einsum('bsgp,ghp->bsgh', states, c_mat)) + d_skip.astype(jnp.float32) * uf
    y = jax.nn.gelu(y.reshape(bsz, s, SSM_WIDTH)).astype(u.dtype)
    z_out, z_gate = jnp.split(y @ w_glu, 2, axis=-1)
    return z_out * jax.nn.sigmoid(z_gate)


def blocked_causal_attention(q, k, v, scale):
    bsz, s, h, dqk = q.shape
    nb = s // Q_BLOCK
    qb = q.reshape(bsz, nb, Q_BLOCK, h, dqk).transpose(1, 0, 2, 3, 4)
    kpos = jnp.arange(s)

    def one_block(args):
        q_blk, start = args
        sc = jnp.einsum('bqhd,bkhd->bhqk', q_blk, k, preferred_element_type=jnp.float32) * scale
        qpos = start + jnp.arange(Q_BLOCK)
        sc = jnp.where(kpos[None, :] <= qpos[:, None], sc, MASK_VALUE)
        p = jax.nn.softmax(sc, axis=-1).astype(v.dtype)
        return jnp.einsum('bhqk,bkhd->bqhd', p, v)

    ob = lax.map(one_block, (qb, jnp.arange(nb) * Q_BLOCK))
    return ob.transpose(1, 0, 2, 3, 4).reshape(bsz, s, h, v.shape[-1])


def mla_mixer(q_lat, kv_lat, k_rope, cos, sin, q_norm, kv_norm, w_uq, w_ukv, w_o):
    bsz, s, _ = q_lat.shape
    q = (rmsnorm(q_lat, q_norm) @ w_uq).reshape(bsz, s, MLA_HEADS, MLA_NOPE + MLA_ROPE)
    q_nope, q_pe = q[..., :MLA_NOPE], q[..., MLA_NOPE:]
    q_pe = apply_rope(q_pe, cos[:, :, None, :], sin[:, :, None, :])
    kv = (rmsnorm(kv_lat, kv_norm) @ w_ukv).reshape(bsz, s, MLA_HEADS, MLA_NOPE + MLA_V)
    k_nope, v = kv[..., :MLA_NOPE], kv[..., MLA_NOPE:]
    k_pe = apply_rope(k_rope, cos, sin)
    k = jnp.concatenate([k_nope, jnp.broadcast_to(k_pe[:, :, None, :], (bsz, s, MLA_HEADS, MLA_ROPE))], axis=-1)
    q = jnp.concatenate([q_nope, q_pe], axis=-1)
    o = blocked_causal_attention(q, k, v, 1.0 / math.sqrt(MLA_NOPE + MLA_ROPE))
    return o.reshape(bsz, s, MLA_WIDTH) @ w_o


def hgrn2_mixer(q, f_logit, i_in, g, lb, g_norm, w_o):
    bsz, s, _ = q.shape
    n_chunks = s // HG_CHUNK

    def to_chunks(t):
        return t.reshape(bsz, n_chunks, HG_CHUNK, HG_HEADS, -1).transpose(1, 0, 3, 2, 4)

    lbf = lb.astype(jnp.float32)
    sig = jax.nn.sigmoid(f_logit.astype(jnp.float32))
    f = lbf + (1.0 - lbf) * sig
    log_f = jnp.log(f)
    k = 1.0 - f
    xs = (to_chunks(jax.nn.silu(q.astype(jnp.float32))), to_chunks(k),
          to_chunks(i_in.astype(jnp.float32)), to_chunks(log_f))
    causal = jnp.tril(jnp.ones((HG_CHUNK, HG_CHUNK), dtype=bool))[:, :, None]

    def chunk_step(state, chunk):
        q_n, k_n, v_n, lf_n = chunk
        b = jnp.cumsum(lf_n, axis=2)
        diff = b[:, :, :, None, :] - b[:, :, None, :, :]
        decay = jnp.where(causal, jnp.exp(jnp.where(causal, diff, 0.0)), 0.0)
        attn = jnp.einsum('bhtd,bhsd,bhtsd->bhts', q_n, k_n, decay)
        o_n = jnp.einsum('bhts,bhse->bhte', attn, v_n) + jnp.einsum('bhtd,bhde->bhte', q_n * jnp.exp(b), state)
        b_last = b[:, :, -1, :]
        k_dec = k_n * jnp.exp(b_last[:, :, None, :] - b)
        state = jnp.exp(b_last)[..., None] * state + jnp.einsum('bhsd,bhse->bhde', k_dec, v_n)
        return state, o_n

    s0 = jnp.zeros((bsz, HG_HEADS, HG_DK, HG_DV), jnp.float32)
    _, o = lax.scan(chunk_step, s0, xs)
    o = o.transpose(1, 0, 3, 2, 4).reshape(bsz, s, HG_HEADS, HG_DV)
    gate = g.astype(jnp.float32).reshape(bsz, s, HG_HEADS, HG_DV)
    o = rmsnorm(o, g_norm) * jax.nn.silu(gate)
    return o.reshape(bsz, s, HG_HEADS * HG_DV).astype(g.dtype) @ w_o


def memory_cross_attention(h, mem_n, w_q, w_kv, w_o):
    bsz, s, _ = h.shape
    m = mem_n.shape[1]
    q = (h @ w_q).reshape(bsz, s, X_HEADS, X_HEAD_DIM)
    k, v = jnp.split(mem_n @ w_kv, 2, axis=-1)
    k = k.reshape(bsz, m, X_HEADS, X_HEAD_DIM)
    v = v.reshape(bsz, m, X_HEADS, X_HEAD_DIM)
    sc = jnp.einsum('bqhd,bkhd->bhqk', q, k, preferred_element_type=jnp.float32) / math.sqrt(X_HEAD_DIM)
    p = jax.nn.softmax(sc, axis=-1).astype(v.dtype)
    o = jnp.einsum('bhqk,bkhd->bqhd', p, v)
    return o.reshape(bsz, s, X_WIDTH) @ w_o


def swiglu_ffn(h, w_gate_up, w_down):
    gt, up = jnp.split(h @ w_gate_up, 2, axis=-1)
    return (jax.nn.silu(gt) * up) @ w_down


def setup_inputs(seed: int = 0) -> dict:
    key = jax.random.key(seed)
    keys = list(jax.random.split(key, 48))
    L = DEPTH

    def nrm(shape, scale):
        return scale * jax.random.normal(keys.pop(), shape, jnp.float32)

    def gain(shape):
        return 1.0 + 0.05 * jax.random.normal(keys.pop(), shape, jnp.float32)

    x = nrm((BATCH, SEQ, D_MODEL), 1.0)
    mem = nrm((BATCH, N_MEM, D_MODEL), 1.0)
    offsets = jax.random.randint(keys.pop(), (BATCH, 1), 0, MAX_POS_OFFSET, dtype=jnp.int32)
    positions = (offsets + jnp.arange(SEQ, dtype=jnp.int32)[None, :]).astype(jnp.int32)
    state_idx = jnp.arange(SSM_STATE, dtype=jnp.float32)
    return {
        "x": x,
        "mem": mem,
        "positions": positions,
        "norm_mix": gain((L, D_MODEL)),
        "w_in": nrm((L, D_MODEL, D_IN), D_MODEL ** -0.5),
        "ssm_lam_re": -0.5 + nrm((L, SSM_GROUPS, SSM_STATE), 0.01),
        "ssm_lam_im": math.pi * state_idx + nrm((L, SSM_GROUPS, SSM_STATE), 0.01),
        "ssm_b_re": nrm((L, SSM_GROUPS, SSM_STATE, SSM_GROUP_CH), (2.0 * SSM_GROUP_CH) ** -0.5),
        "ssm_b_im": nrm((L, SSM_GROUPS, SSM_STATE, SSM_GROUP_CH), (2.0 * SSM_GROUP_CH) ** -0.5),
        "ssm_c_re": nrm((L, SSM_GROUPS, SSM_GROUP_CH, SSM_STATE), (2.0 * SSM_STATE) ** -0.5),
        "ssm_c_im": nrm((L, SSM_GROUPS, SSM_GROUP_CH, SSM_STATE), (2.0 * SSM_STATE) ** -0.5),
        "ssm_d": nrm((L, SSM_GROUPS, SSM_GROUP_CH), 1.0),
        "ssm_log_step": jax.random.uniform(keys.pop(), (L, SSM_GROUPS), jnp.float32, math.log(1e-3), math.log(1e-1)),
        "ssm_w_glu": nrm((L, SSM_WIDTH, 2 * D_MODEL), SSM_WIDTH ** -0.5),
        "mla_q_norm": gain((L, MLA_Q_RANK)),
        "mla_kv_norm": gain((L, MLA_KV_RANK)),
        "mla_w_uq": nrm((L, MLA_Q_RANK, MLA_HEADS * (MLA_NOPE + MLA_ROPE)), MLA_Q_RANK ** -0.5),
        "mla_w_ukv": nrm((L, MLA_KV_RANK, MLA_HEADS * (MLA_NOPE + MLA_V)), MLA_KV_RANK ** -0.5),
        "mla_w_o": nrm((L, MLA_WIDTH, D_MODEL), MLA_WIDTH ** -0.5),
        "hg_lb": nrm((L, HG_HEADS * HG_DK), 1.0),
        "hg_g_norm": gain((L, HG_DV)),
        "hg_w_o": nrm((L, HG_HEADS * HG_DV, D_MODEL), (HG_HEADS * HG_DV) ** -0.5),
        "w_out": nrm((L, D_MODEL, D_MODEL), D_MODEL ** -0.5),
        "norm_cross": gain((L, D_MODEL)),
        "norm_mem": gain((L, D_MODEL)),
        "x_w_q": nrm((L, D_MODEL, X_WIDTH), D_MODEL ** -0.5),
        "x_w_kv": nrm((L, D_MODEL, 2 * X_WIDTH), D_MODEL ** -0.5),
        "x_w_o": nrm((L, X_WIDTH, D_MODEL), X_WIDTH ** -0.5),
        "norm_ffn": gain((L, D_MODEL)),
        "ffn_w_gate_up": nrm((L, D_MODEL, 2 * D_FF), D_MODEL ** -0.5),
        "ffn_w_down": nrm((L, D_FF, D_MODEL), D_FF ** -0.5),
        "norm_final": gain((D_MODEL,)),
    }


def reference(x, mem, positions, norm_mix, w_in, ssm_lam_re, ssm_lam_im, ssm_b_re, ssm_b_im,
              ssm_c_re, ssm_c_im, ssm_d, ssm_log_step, ssm_w_glu, mla_q_norm, mla_kv_norm,
              mla_w_uq, mla_w_ukv, mla_w_o, hg_lb, hg_g_norm, hg_w_o, w_out, norm_cross, norm_mem,
              x_w_q, x_w_kv, x_w_o, norm_ffn, ffn_w_gate_up, ffn_w_down, norm_final):
    bsz, s, _ = x.shape
    cos, sin = rope_tables(positions)
    lb_p = jax.nn.softmax(hg_lb.astype(jnp.float32), axis=0)
    lower_bounds = jnp.cumsum(lb_p, axis=0) - lb_p[0:1]
    split_at = np.cumsum(IN_SPLITS)[:-1].tolist()

    for l in range(DEPTH):
        h = rmsnorm(x, norm_mix[l])
        (u_ssm, q_lat, kv_lat, k_rope, hg_q, hg_f, hg_i, hg_g, gate_logits) = jnp.split(h @ w_in[l], split_at, axis=-1)
        y_ssm = s5_mixer(u_ssm, ssm_lam_re[l], ssm_lam_im[l], ssm_b_re[l], ssm_b_im[l],
                         ssm_c_re[l], ssm_c_im[l], ssm_d[l], ssm_log_step[l], ssm_w_glu[l])
        y_mla = mla_mixer(q_lat, kv_lat, k_rope, cos, sin, mla_q_norm[l], mla_kv_norm[l],
                          mla_w_uq[l], mla_w_ukv[l], mla_w_o[l])
        y_hg = hgrn2_mixer(hg_q, hg_f, hg_i, hg_g, lower_bounds[l], hg_g_norm[l], hg_w_o[l])
        gates = jax.nn.sigmoid(gate_logits.astype(jnp.float32)).reshape(bsz, s, N_BRANCH, D_MODEL)
        merged = (gates[:, :, 0] * y_ssm.astype(jnp.float32)
                  + gates[:, :, 1] * y_mla.astype(jnp.float32)
                  + gates[:, :, 2] * y_hg.astype(jnp.float32)).astype(x.dtype)
        x = x + merged @ w_out[l]
        x = x + memory_cross_attention(rmsnorm(x, norm_cross[l]), rmsnorm(mem, norm_mem[l]),
                                       x_w_q[l], x_w_kv[l], x_w_o[l])
        x = x + swiglu_ffn(rmsnorm(x, norm_ffn[l]), ffn_w_gate_up[l], ffn_w_down[l])
    return rmsnorm(x, norm_final)
```

```cpp
#include <hip/hip_runtime.h>
#include <cstdio>
#include <cstdint>

#ifndef MK_MULTI
#define MK_MULTI 0
#endif

#define LAS __attribute__((address_space(3)))
#define GAS __attribute__((address_space(1)))
typedef unsigned short bf16_t;
typedef short bf16x8 __attribute__((ext_vector_type(8)));
typedef float f32x4 __attribute__((ext_vector_type(4)));
typedef float f32x2 __attribute__((ext_vector_type(2)));
typedef unsigned u32x4 __attribute__((ext_vector_type(4)));
typedef unsigned u32x2 __attribute__((ext_vector_type(2)));
typedef __bf16 bf16x2_t __attribute__((ext_vector_type(2)));

constexpr int NB = 4, SEQ = 4096, T = NB * SEQ, DM = 1024, NL = 2, NMEM = 256;
constexpr int DIN = 6432, DFF = 2816;
constexpr float RMS_EPS = 1e-6f;
constexpr float LOG2E = 1.4426950408889634f;
constexpr int NWAVES = 8, NTHREADS = 512;

constexpr size_t MiB = 1u << 20;
constexpr size_t WS_CTL = 0, CTL_BYTES = 1 * MiB;
constexpr size_t WS_COS = 1 * MiB, WS_SIN = 2 * MiB;
constexpr size_t WS_MEMK = 3 * MiB, WS_MEMVT = 5 * MiB;
constexpr size_t WS_TOEP = 7 * MiB, WS_BMAT = 9 * MiB, WS_CMAT = 17 * MiB;
constexpr size_t WS_WBIG = 26 * MiB;
constexpr size_t WS_WGLU = 39 * MiB, WS_WUQ = 41 * MiB, WS_WUK = 42 * MiB, WS_WUV = 42 * MiB + 512 * 1024;
constexpr size_t WS_WMO = 43 * MiB, WS_WHO = 44 * MiB, WS_WOUT = 45 * MiB, WS_WXQ = 47 * MiB, WS_WXO = 48 * MiB;
constexpr size_t WS_SUMS = 49 * MiB, WS_XST = 53 * MiB, WS_HGDEC = 57 * MiB;
constexpr size_t WS_XB = 58 * MiB;
constexpr size_t WS_HGQ = 90 * MiB;
constexpr size_t WS_Q = 106 * MiB;
constexpr size_t WS_YS = 130 * MiB;
constexpr size_t WS_UP = 146 * MiB;
constexpr size_t WS_QLAT = 162 * MiB;
constexpr size_t WS_KVLAT = 178 * MiB;
constexpr size_t WS_KPE = 186 * MiB;
constexpr size_t WS_HGXF = 187 * MiB;
constexpr size_t WS_HGI = 203 * MiB;
constexpr size_t WS_HGSG = 219 * MiB;
constexpr size_t WS_HGUS = 235 * MiB;
constexpr size_t WS_GT = 146 * MiB, WS_ZT = 178 * MiB, WS_MG = 210 * MiB;
constexpr size_t WS_QX = 90 * MiB, WS_OX = 106 * MiB, WS_WGU = 122 * MiB, WS_WD = 133 * MiB;
constexpr size_t WS_H = 146 * MiB;
constexpr size_t WS_MEMN = 235 * MiB, WS_WXK = 237 * MiB, WS_WXV = 239 * MiB;
constexpr size_t WS_END = 256 * MiB;
constexpr int CW_TMO = 0, CW_BAR = 4096;
constexpr size_t CTL_SSQ = 64 * 1024;
__host__ __device__ constexpr int ssq_idx(int l, int k) { return l * 5 + k; }

__device__ __forceinline__ float bf2f(unsigned h) { return __uint_as_float(h << 16); }
__device__ __forceinline__ unsigned pk2(float lo, float hi) { f32x2 v = {lo, hi}; bf16x2_t b = __builtin_convertvector(v, bf16x2_t); return __builtin_bit_cast(unsigned, b); }
__device__ __forceinline__ u32x4 pack8(const f32x4 a, const f32x4 b) { u32x4 w; w.x = pk2(a[0], a[1]); w.y = pk2(a[2], a[3]); w.z = pk2(b[0], b[1]); w.w = pk2(b[2], b[3]); return w; }
__device__ __forceinline__ void unpack8(const u32x4 w, f32x4& a, f32x4& b) {
    a[0] = __uint_as_float(w.x << 16); a[1] = __uint_as_float(w.x & 0xffff0000u); a[2] = __uint_as_float(w.y << 16); a[3] = __uint_as_float(w.y & 0xffff0000u);
    b[0] = __uint_as_float(w.z << 16); b[1] = __uint_as_float(w.z & 0xffff0000u); b[2] = __uint_as_float(w.w << 16); b[3] = __uint_as_float(w.w & 0xffff0000u); }
__device__ __forceinline__ float fexp2(float x) { return __builtin_amdgcn_exp2f(x); }
__device__ __forceinline__ float frcp(float x) { return __builtin_amdgcn_rcpf(x); }
__device__ __forceinline__ float sigmoidf_(float x) { return frcp(1.f + fexp2(-x * LOG2E)); }
__device__ __forceinline__ float siluf_(float x) { return x * sigmoidf_(x); }
__device__ __forceinline__ float geluf_(float x) { const float u = 0.7978845608028654f * (x + 0.044715f * x * x * x); return x * frcp(1.f + fexp2(-2.f * LOG2E * u)); }
__device__ __forceinline__ float rstd_of(float ssq, float inv_n) { return __builtin_amdgcn_rsqf(ssq * inv_n + RMS_EPS); }
__device__ __forceinline__ float wave_sum(float v) {
#pragma unroll
    for (int o = 1; o < 64; o <<= 1) v += __shfl_xor(v, o);
    return v;
}
__device__ __forceinline__ void sincos_rad(double a, float& s, float& c) {
    double rev = a * 0.15915494309189533576888; rev -= __builtin_rint(rev); const float fr = (float)rev;
    s = __builtin_amdgcn_sinf(fr); c = __builtin_amdgcn_cosf(fr);
}
#define LDS_WAIT() asm volatile("s_waitcnt lgkmcnt(0)" ::: "memory")
#define VM_WAIT() asm volatile("s_waitcnt vmcnt(0)" ::: "memory")

namespace pg8 {
constexpr int BM = 256, BK = 64, HALF = 128, HTB = HALF * BK * 2, STAGE_BYTES = 8 * HTB, NXCD = 8, WGM = 8;
__host__ __device__ __forceinline__ int lds_byte(int r, int c) { const int st = (r >> 4) * 2 + (c >> 5), rr = r & 15, cc = c & 31, ob = rr * 64 + cc * 2; return st * 1024 + (ob ^ (((ob >> 9) & 1) << 5)); }
__host__ __device__ __forceinline__ void stage_rc(int b, int& R, int& C) { const int st = b / 1024, sb = b % 1024, swz = sb ^ (((sb >> 9) & 1) << 5); R = (st >> 1) * 16 + swz / 64; C = (st & 1) * 32 + (swz % 64) / 2; }
__host__ __device__ __forceinline__ int perm32(int rho) { const int n = rho >> 4, i = rho & 15; return 8 * (i >> 2) + 4 * n + (i & 3); }

struct Unit { int pm, pn; };
struct Gemm {
    const char* A; const char* Bt; int nM, nN, K;
    int rsA, c16A; long kstepA, hstepA, tstepA;
    int rsB, c16B, offB; long kstepB, hstepB, tstepB, zstepB;
};
__device__ __forceinline__ Gemm mk(const bf16_t* A, int lda, const bf16_t* Bt, int ldb, int M, int N, int K) {
    Gemm g; g.A = (const char*)A; g.Bt = (const char*)Bt; g.nM = M / BM; g.nN = N / BM; g.K = K;
    g.rsA = lda * 2; g.c16A = 32; g.kstepA = BK * 2; g.hstepA = (long)HALF * lda * 2; g.tstepA = 2 * g.hstepA;
    g.rsB = ldb * 2; g.c16B = 32; g.offB = 0; g.kstepB = BK * 2; g.hstepB = (long)HALF * ldb * 2; g.tstepB = 2 * g.hstepB; g.zstepB = 0;
    return g;
}
struct StaticOrder {
    int nM, nN, nwg, G, c;
    __device__ __forceinline__ void init(int nM_, int nN_, int G_, int c_) { nM = nM_; nN = nN_; nwg = nM * nN; G = G_; c = c_; }
    __device__ __forceinline__ bool next(int i, Unit& u) const {
        const long L = (long)i * G + c; if (L >= nwg) return false;
        int wgid = (int)L; { const int q = nwg / NXCD, r = nwg % NXCD, xcd = wgid % NXCD, off = wgid / NXCD; wgid = (xcd < r ? xcd * (q + 1) : r * (q + 1) + (xcd - r) * q) + off; }
        const int nig = WGM * nN, gid = wgid / nig, fm = gid * WGM, gsz = (nM - fm) < WGM ? (nM - fm) : WGM;
        u.pm = fm + ((wgid % nig) % gsz); u.pn = (wgid % nig) / gsz; return true;
    }
};

template <class Epi>
__device__ __forceinline__ void gemm_phase(LAS unsigned char* lds, const int tid, const Gemm g, const StaticOrder& S, const Epi& E) {
    const int wid = __builtin_amdgcn_readfirstlane(tid >> 6), lane = tid & 63, wr = wid >> 2, wc = wid & 3, fr = lane & 15, fq = lane >> 4;
    const int nt = g.K / BK;
    unsigned voffA[2], voffB[2];
#pragma unroll
    for (int i = 0; i < 2; ++i) { int R, C; stage_rc(tid * 16 + i * 8192, R, C); const int Rb = (R & ~31) + perm32(R & 31);
        voffA[i] = (unsigned)(R * g.rsA + (C >> 4) * g.c16A + (C & 15) * 2); voffB[i] = (unsigned)(g.offB + Rb * g.rsB + (C >> 4) * g.c16B + (C & 15) * 2); }
    const long kstepA = g.kstepA, kstepB = g.kstepB, hstepA = g.hstepA, hstepB = g.hstepB;
    const unsigned ldsw = (unsigned)wid * 1024u;
    const int aoff = lds_byte(wr * 64 + fr, fq * 8), boff = lds_byte(wc * 32 + fr, fq * 8);
#define PG8_SA(b, h) (((b) * 2 + (h)) * HTB)
#define PG8_SB(b, h) ((4 + (b) * 2 + (h)) * HTB)
#define PG8_STAGE(bufoff, gbase, voff) do { _Pragma("unroll") for (int _i = 0; _i < 2; ++_i) \
        __builtin_amdgcn_global_load_lds((const unsigned*)((const char*)(gbase) + (voff)[_i]), (LAS unsigned*)(lds + (bufoff) + ldsw + _i * 8192), 16, 0, 0); } while (0)
#define PG8_LDA(dst, b, h) do { _Pragma("unroll") for (int m = 0; m < 4; ++m) _Pragma("unroll") for (int k = 0; k < 2; ++k) dst[m][k] = *(const LAS bf16x8*)(lds + PG8_SA(b, h) + aoff + m * 2048 + k * 1024); } while (0)
#define PG8_LDB(dst, b, h) do { _Pragma("unroll") for (int n = 0; n < 2; ++n) _Pragma("unroll") for (int k = 0; k < 2; ++k) dst[n][k] = *(const LAS bf16x8*)(lds + PG8_SB(b, h) + boff + n * 2048 + k * 1024); } while (0)
#define PG8_MMA(ai, bj, At, Bt) do { __builtin_amdgcn_s_setprio(1); _Pragma("unroll") for (int m = 0; m < 4; ++m) _Pragma("unroll") for (int n = 0; n < 2; ++n) _Pragma("unroll") for (int k = 0; k < 2; ++k) \
        acc[ai][bj][m][n] = __builtin_amdgcn_mfma_f32_16x16x32_bf16(Bt[n][k], At[m][k], acc[ai][bj][m][n], 0, 0, 0); __builtin_amdgcn_s_setprio(0); } while (0)
#define PG8_WAIT_V(n) asm volatile("s_waitcnt vmcnt(" #n ")" ::: "memory")
#define PG8_WAIT_L(n) asm volatile("s_waitcnt lgkmcnt(" #n ")" ::: "memory")
#define PG8_BAR __builtin_amdgcn_s_barrier()
#define PG8_SCHED __builtin_amdgcn_sched_barrier(0)
    Unit cur, nxt; int ui = 0;
    if (!S.next(0, cur)) return;
    f32x4 acc[2][2][4][2];
#pragma unroll
    for (int a = 0; a < 2; ++a)
#pragma unroll
        for (int b = 0; b < 2; ++b)
#pragma unroll
            for (int m = 0; m < 4; ++m)
#pragma unroll
                for (int n = 0; n < 2; ++n) acc[a][b][m][n] = (f32x4){0.f, 0.f, 0.f, 0.f};
    bf16x8 At[4][2], B0[2][2], B1[2][2];
    const char* cA = g.A + (long)cur.pm * g.tstepA; const char* cB = g.Bt + (long)cur.pn * g.tstepB + (long)cur.pm * g.zstepB;
    PG8_STAGE(PG8_SB(0, 0), cB, voffB); PG8_STAGE(PG8_SB(0, 1), cB + hstepB, voffB); PG8_STAGE(PG8_SA(0, 0), cA, voffA); PG8_STAGE(PG8_SA(0, 1), cA + hstepA, voffA);
    if (wr == 1) PG8_BAR;
    PG8_WAIT_V(2); PG8_BAR;
    PG8_STAGE(PG8_SB(1, 0), cB + kstepB, voffB); PG8_STAGE(PG8_SA(1, 0), cA + kstepA, voffA); PG8_STAGE(PG8_SB(1, 1), cB + hstepB + kstepB, voffB);
    PG8_WAIT_V(6); PG8_BAR;
    for (;;) {
        const bool has_next = S.next(ui + 1, nxt);
        const char* nA = has_next ? g.A + (long)nxt.pm * g.tstepA : cA; const char* nB = has_next ? g.Bt + (long)nxt.pn * g.tstepB + (long)nxt.pm * g.zstepB : cB;
        for (int t = 0; t < nt; t += 2) {
            const bool last = (t == nt - 2);
            const char* a1 = cA + (long)(t + 1) * kstepA;
            const char* a2 = last ? nA : cA + (long)(t + 2) * kstepA; const char* b2 = last ? nB : cB + (long)(t + 2) * kstepB;
            const char* a3 = a2 + kstepA; const char* b3 = b2 + kstepB;
            PG8_LDB(B0, 0, 0); PG8_LDB(B1, 0, 1); PG8_SCHED; PG8_LDA(At, 0, 0); PG8_STAGE(PG8_SA(1, 1), a1 + hstepA, voffA);
            PG8_WAIT_V(8); PG8_WAIT_L(0); PG8_BAR; PG8_MMA(0, 0, At, B0); PG8_MMA(0, 1, At, B1); PG8_BAR; PG8_SCHED;
            PG8_LDA(At, 0, 1); PG8_STAGE(PG8_SB(0, 0), b2, voffB); PG8_STAGE(PG8_SB(0, 1), b2 + hstepB, voffB); PG8_STAGE(PG8_SA(0, 0), a2, voffA);
            PG8_WAIT_V(8); PG8_WAIT_L(0); PG8_BAR; PG8_MMA(1, 0, At, B0); PG8_MMA(1, 1, At, B1); PG8_BAR; PG8_SCHED;
            PG8_LDB(B0, 1, 0); PG8_LDB(B1, 1, 1); PG8_SCHED; PG8_LDA(At, 1, 0); PG8_STAGE(PG8_SA(0, 1), a2 + hstepA, voffA);
            PG8_WAIT_V(8); PG8_WAIT_L(0); PG8_BAR; PG8_MMA(0, 0, At, B0); PG8_MMA(0, 1, At, B1); PG8_BAR; PG8_SCHED;
            PG8_LDA(At, 1, 1); PG8_STAGE(PG8_SB(1, 0), b3, voffB); PG8_STAGE(PG8_SB(1, 1), b3 + hstepB, voffB); PG8_STAGE(PG8_SA(1, 0), a3, voffA);
            PG8_WAIT_V(8); PG8_WAIT_L(0); PG8_BAR; PG8_MMA(1, 0, At, B0); PG8_MMA(1, 1, At, B1); PG8_BAR; PG8_SCHED;
        }
        if (wr == 0) PG8_BAR;
        { int fr_ = fr, fq_ = fq; asm volatile("" : "+v"(fr_), "+v"(fq_)); E(acc, cur, wr, wc, fr_, fq_); }
        if (!has_next) break;
#pragma unroll
        for (int a = 0; a < 2; ++a)
#pragma unroll
            for (int b = 0; b < 2; ++b)
#pragma unroll
                for (int m = 0; m < 4; ++m)
#pragma unroll
                    for (int n = 0; n < 2; ++n) acc[a][b][m][n] = (f32x4){0.f, 0.f, 0.f, 0.f};
        cur = nxt; cA = nA; cB = nB; ++ui;
        if (wr == 1) PG8_BAR;
    }
    PG8_WAIT_V(0);
    PG8_BAR;
#undef PG8_SA
#undef PG8_SB
#undef PG8_STAGE
#undef PG8_LDA
#undef PG8_LDB
#undef PG8_MMA
#undef PG8_WAIT_V
#undef PG8_WAIT_L
#undef PG8_BAR
#undef PG8_SCHED
}
}
typedef f32x4 AccT[2][2][4][2];
#define EPI_ROWS(ai, m) (u.pm * 256 + (ai) * 128 + wr * 64 + (m) * 16 + fr)
#define EPI_COL0(bj) (u.pn * 256 + (bj) * 128 + wc * 32 + 8 * fq)
#define EPI_FOR_AM _Pragma("unroll") for (int ai = 0; ai < 2; ++ai) _Pragma("unroll") for (int m = 0; m < 4; ++m)
#define EPI_FOR_BJ _Pragma("unroll") for (int bj = 0; bj < 2; ++bj)

__device__ __forceinline__ void ssq_add(float* ssq, int row, float s, int fq) { s += __shfl_xor(s, 16); s += __shfl_xor(s, 32); if (fq == 0) atomicAdd(ssq + row, s); }
__device__ __forceinline__ float sq8(const f32x4 a, const f32x4 b) { return (a[0] * a[0] + a[1] * a[1]) + (a[2] * a[2] + a[3] * a[3]) + (b[0] * b[0] + b[1] * b[1]) + (b[2] * b[2] + b[3] * b[3]); }

struct EpiInProj {
    static constexpr bool PERM = true;
    unsigned char* ws; int l;
    template <int KIND> __device__ __forceinline__ void body(const AccT& acc, const pg8::Unit& u, int wr, int wc, int fr, int fq, int cbase) const {
        const float* ssq_mix = (const float*)(ws + CTL_SSQ) + (size_t)ssq_idx(l, 0) * T; float* ssq_q = (float*)(ws + CTL_SSQ) + (size_t)ssq_idx(l, 1) * T; float* ssq_kv = (float*)(ws + CTL_SSQ) + (size_t)ssq_idx(l, 2) * T;
        bf16_t* Up = (bf16_t*)(ws + WS_UP); bf16_t* qlat = (bf16_t*)(ws + WS_QLAT); bf16_t* kvlat = (bf16_t*)(ws + WS_KVLAT); bf16_t* hgq = (bf16_t*)(ws + WS_HGQ); bf16_t* hgi = (bf16_t*)(ws + WS_HGI); bf16_t* kpe = (bf16_t*)(ws + WS_KPE);
        _Float16* hgxf = (_Float16*)(ws + WS_HGXF); const float* cosT = (const float*)(ws + WS_COS); const float* sinT = (const float*)(ws + WS_SIN);
        EPI_FOR_AM { const int row = EPI_ROWS(ai, m); const float rs = rstd_of(ssq_mix[row], 1.f / DM); float sacc = 0.f;
            EPI_FOR_BJ { const int col = EPI_COL0(bj) - cbase; f32x4 v0 = acc[ai][bj][m][0] * rs, v1 = acc[ai][bj][m][1] * rs;
                if (KIND == 0) { const int g = col >> 4, hp = col & 15, ch = row >> 6, s = row & 63; *(u32x4*)(Up + ((size_t)(g * 256 + ch) * 1024 + s * 16 + hp)) = pack8(v0, v1); }
                if (KIND == 1) { sacc += sq8(v0, v1); *(u32x4*)(qlat + (size_t)row * 512 + col) = pack8(v0, v1); }
                if (KIND == 2) { sacc += sq8(v0, v1); *(u32x4*)(kvlat + (size_t)row * 256 + col) = pack8(v0, v1); }
                if (KIND == 3) { _Pragma("unroll") for (int i = 0; i < 4; ++i) { v0[i] = siluf_(v0[i]); v1[i] = siluf_(v1[i]); } *(u32x4*)(hgq + (size_t)row * 512 + col) = pack8(v0, v1); }
                if (KIND == 4) { typedef _Float16 h8 __attribute__((ext_vector_type(8))); h8 h; _Pragma("unroll") for (int i = 0; i < 4; ++i) { h[i] = (_Float16)v0[i]; h[4 + i] = (_Float16)v1[i]; } *(h8*)(hgxf + (size_t)row * 512 + col) = h; }
                if (KIND == 5) { *(u32x4*)(hgi + (size_t)row * 512 + col) = pack8(v0, v1); }
                if (KIND == 6) { if (bj == 0 && wc == 0) {
                        const int j0 = 8 * (fq & 1); const f32x4 c0 = *(const f32x4*)(cosT + (size_t)row * 16 + j0), c1 = *(const f32x4*)(cosT + (size_t)row * 16 + j0 + 4);
                        const f32x4 s0 = *(const f32x4*)(sinT + (size_t)row * 16 + j0), s1 = *(const f32x4*)(sinT + (size_t)row * 16 + j0 + 4); const float sg = (fq < 2) ? -1.f : 1.f;
                        f32x4 o0, o1; _Pragma("unroll") for (int i = 0; i < 4; ++i) { const float p0 = __shfl_xor(v0[i], 32), p1 = __shfl_xor(v1[i], 32); o0[i] = v0[i] * c0[i] + sg * p0 * s0[i]; o1[i] = v1[i] * c1[i] + sg * p1 * s1[i]; }
                        *(u32x4*)(kpe + (size_t)row * 32 + 8 * fq) = pack8(o0, o1); } }
            }
            if (KIND == 1) ssq_add(ssq_q, row, sacc, fq);
            if (KIND == 2) ssq_add(ssq_kv, row, sacc, fq);
        }
    }
    __device__ __forceinline__ void operator()(const AccT& acc, const pg8::Unit& u, int wr, int wc, int fr, int fq) const {
        const int pn = u.pn;
        if (pn < 2) body<0>(acc, u, wr, wc, fr, fq, 0);
        else if (pn < 4) body<1>(acc, u, wr, wc, fr, fq, 512);
        else if (pn < 5) body<2>(acc, u, wr, wc, fr, fq, 1024);
        else if (pn < 7) body<3>(acc, u, wr, wc, fr, fq, 1280);
        else if (pn < 9) body<4>(acc, u, wr, wc, fr, fq, 1792);
        else if (pn < 11) body<5>(acc, u, wr, wc, fr, fq, 2304);
        else body<6>(acc, u, wr, wc, fr, fq, 2816);
    }
};
struct EpiQ {
    static constexpr bool PERM = true;
    const float* ssq; bf16_t* Q; const float* cosT; const float* sinT; float scale;
    __device__ __forceinline__ void operator()(const AccT& acc, const pg8::Unit& u, int wr, int wc, int fr, int fq) const {
        EPI_FOR_AM { const int row = EPI_ROWS(ai, m); const float rs = rstd_of(ssq[row], 1.f / 512) * scale;
            EPI_FOR_BJ { const int col = EPI_COL0(bj); f32x4 v0 = acc[ai][bj][m][0] * rs, v1 = acc[ai][bj][m][1] * rs; const int gi = u.pn * 8 + bj * 4 + wc;
                if (gi % 3 == 2) { const int j0 = 8 * (fq & 1); const f32x4 c0 = *(const f32x4*)(cosT + (size_t)row * 16 + j0), c1 = *(const f32x4*)(cosT + (size_t)row * 16 + j0 + 4);
                    const f32x4 s0 = *(const f32x4*)(sinT + (size_t)row * 16 + j0), s1 = *(const f32x4*)(sinT + (size_t)row * 16 + j0 + 4); const float sg = (fq < 2) ? -1.f : 1.f;
                    f32x4 o0, o1; _Pragma("unroll") for (int i = 0; i < 4; ++i) { const float p0 = __shfl_xor(v0[i], 32), p1 = __shfl_xor(v1[i], 32); o0[i] = v0[i] * c0[i] + sg * p0 * s0[i]; o1[i] = v1[i] * c1[i] + sg * p1 * s1[i]; }
                    v0 = o0; v1 = o1; }
                *(u32x4*)(Q + (size_t)row * 768 + col) = pack8(v0, v1); } }
    }
};
template <int ACT> struct EpiRowBf16 {
    static constexpr bool PERM = true;
    const float* ssq; float inv_n; float scale; bf16_t* O; int ldc;
    __device__ __forceinline__ void operator()(const AccT& acc, const pg8::Unit& u, int wr, int wc, int fr, int fq) const {
        EPI_FOR_AM { const int row = EPI_ROWS(ai, m); const float rs = (ssq ? rstd_of(ssq[row], inv_n) : 1.f) * scale;
            EPI_FOR_BJ { const int col = EPI_COL0(bj); f32x4 v0 = acc[ai][bj][m][0] * rs, v1 = acc[ai][bj][m][1] * rs;
                if (ACT == 1) { _Pragma("unroll") for (int i = 0; i < 4; ++i) { v0[i] = siluf_(v0[i]); v1[i] = siluf_(v1[i]); } }
                if (ACT == 2) { _Pragma("unroll") for (int i = 0; i < 4; ++i) { v0[i] = sigmoidf_(v0[i]); v1[i] = sigmoidf_(v1[i]); } }
                *(u32x4*)(O + (size_t)row * ldc + col) = pack8(v0, v1); } }
    }
};
struct EpiColBf16 {
    static constexpr bool PERM = true;
    const float* ssq; float inv_n; bf16_t* O; int ldc;
    __device__ __forceinline__ void operator()(const AccT& acc, const pg8::Unit& u, int wr, int wc, int fr, int fq) const {
        EPI_FOR_BJ { const int col = EPI_COL0(bj); f32x4 r0 = *(const f32x4*)(ssq + col), r1 = *(const f32x4*)(ssq + col + 4);
            _Pragma("unroll") for (int i = 0; i < 4; ++i) { r0[i] = rstd_of(r0[i], inv_n); r1[i] = rstd_of(r1[i], inv_n); }
            EPI_FOR_AM { const int row = EPI_ROWS(ai, m); *(u32x4*)(O + (size_t)row * ldc + col) = pack8(acc[ai][bj][m][0] * r0, acc[ai][bj][m][1] * r1); } }
    }
};
template <int MODE> struct EpiMerge {
    static constexpr bool PERM = true;
    const bf16_t* GT; const bf16_t* ZT; bf16_t* MG;
    __device__ __forceinline__ void operator()(const AccT& acc, const pg8::Unit& u, int wr, int wc, int fr, int fq) const {
        EPI_FOR_AM { const int row = EPI_ROWS(ai, m);
            EPI_FOR_BJ { const size_t off = (size_t)row * 1024 + EPI_COL0(bj); f32x4 g0, g1; unpack8(*(const u32x4*)(GT + off), g0, g1); f32x4 v0 = acc[ai][bj][m][0], v1 = acc[ai][bj][m][1];
                if (MODE == 0) { f32x4 z0, z1; unpack8(*(const u32x4*)(ZT + off), z0, z1); _Pragma("unroll") for (int i = 0; i < 4; ++i) { v0[i] = g0[i] * z0[i] * sigmoidf_(v0[i]); v1[i] = g1[i] * z1[i] * sigmoidf_(v1[i]); } }
                else { f32x4 p0, p1; unpack8(*(const u32x4*)(MG + off), p0, p1); v0 = p0 + g0 * v0; v1 = p1 + g1 * v1; }
                *(u32x4*)(MG + off) = pack8(v0, v1); } }
    }
};
struct EpiResid {
    static constexpr bool PERM = true;
    const float* Xin; float* X; bf16_t* XB; float* ssq;
    __device__ __forceinline__ void operator()(const AccT& acc, const pg8::Unit& u, int wr, int wc, int fr, int fq) const {
        EPI_FOR_AM { const int row = EPI_ROWS(ai, m); float sacc = 0.f;
            EPI_FOR_BJ { const size_t off = (size_t)row * 1024 + EPI_COL0(bj); const f32x4 v0 = *(const f32x4*)(Xin + off) + acc[ai][bj][m][0], v1 = *(const f32x4*)(Xin + off + 4) + acc[ai][bj][m][1];
                *(f32x4*)(X + off) = v0; *(f32x4*)(X + off + 4) = v1; *(u32x4*)(XB + off) = pack8(v0, v1); sacc += sq8(v0, v1); }
            ssq_add(ssq, row, sacc, fq); }
    }
};
struct EpiSwiGLU {
    static constexpr bool PERM = true;
    const float* ssq; bf16_t* H;
    __device__ __forceinline__ void operator()(const AccT& acc, const pg8::Unit& u, int wr, int wc, int fr, int fq) const {
        EPI_FOR_AM { const int row = EPI_ROWS(ai, m); const float rs = rstd_of(ssq[row], 1.f / DM);
            f32x4 g0 = acc[ai][0][m][0] * rs, g1 = acc[ai][0][m][1] * rs; const f32x4 u0 = acc[ai][1][m][0] * rs, u1 = acc[ai][1][m][1] * rs;
            _Pragma("unroll") for (int i = 0; i < 4; ++i) { g0[i] = siluf_(g0[i]) * u0[i]; g1[i] = siluf_(g1[i]) * u1[i]; }
            *(u32x4*)(H + (size_t)row * DFF + u.pn * 128 + wc * 32 + 8 * fq) = pack8(g0, g1); }
    }
};

#define XB_TMO      128
#define XB_XCNT(j)  (256  + 64 * (j))
#define XB_XSUB(j)  (1280 + 64 * (j))
#define XB_XGEN(j)  (2304 + 64 * (j))
#define XB_TOP      3328
#define XB_TOPGEN   3392
#define XCD_BAR_WORDS 3456
#define XB_SPIN_CAP (1u << 18)
__device__ __forceinline__ unsigned xb_ld(unsigned* p)              { return __hip_atomic_load(p, __ATOMIC_RELAXED, __HIP_MEMORY_SCOPE_AGENT); }
__device__ __forceinline__ unsigned xb_add(unsigned* p, unsigned v) { return __hip_atomic_fetch_add(p, v, __ATOMIC_RELAXED, __HIP_MEMORY_SCOPE_AGENT); }
__device__ __forceinline__ unsigned xb_xcc_id() { return (unsigned)__builtin_amdgcn_s_getreg((3 << 11) | 20) & 0xFu; }
#define XB_SPIN(cond, bar) do { unsigned _sp = 0; while (cond) { __builtin_amdgcn_s_sleep(1); \
    if ((++_sp & 255u) == 0u) { if (xb_ld(&(bar)[XB_TMO])) break; if (_sp > XB_SPIN_CAP) { atomicAdd(&(bar)[XB_TMO], 1u); break; } } } } while (0)
struct XcdBarrier { unsigned* bar; unsigned x; volatile LAS unsigned* st; };
__device__ __forceinline__ XcdBarrier xcd_barrier_post(unsigned* bar, volatile LAS unsigned* st) {
    XcdBarrier b; b.bar = bar; b.x = xb_xcc_id(); b.st = st;
    if (threadIdx.x == 0) (void)xb_add(&bar[XB_XCNT(b.x)], 1u);
    return b;
}
__device__ __forceinline__ void xcd_barrier_complete(unsigned* bar, unsigned x, unsigned& nloc, unsigned& nx) {
    const unsigned G = gridDim.x * gridDim.y * gridDim.z;
    unsigned sum, cnt, mine, sp = 0u;
    for (;;) {
        sum = 0u; cnt = 0u; mine = 0u;
#pragma unroll
        for (unsigned j = 0; j < 16; ++j) { const unsigned c = xb_ld(&bar[XB_XCNT(j)]); sum += c; cnt += (c > 0u) ? 1u : 0u; mine = (j == x) ? c : mine; }
        if (sum == G) break;
        __builtin_amdgcn_s_sleep(1);
        if ((++sp & 255u) == 0u) { if (xb_ld(&bar[XB_TMO])) break; if (sp > XB_SPIN_CAP) { atomicAdd(&bar[XB_TMO], 1u); break; } }
    }
    nloc = mine > 0u ? mine : 1u; nx = cnt > 0u ? cnt : 1u;
}
__device__ __forceinline__ void xcd_barrier(const XcdBarrier& b) {
    asm volatile("s_waitcnt vmcnt(0)" ::: "memory");
    __syncthreads();
    if (threadIdx.x == 0) {
        unsigned* bar = b.bar;
        __builtin_amdgcn_s_waitcnt(0);
        unsigned nloc = b.st[0], nx = b.st[1];
        if (nloc == 0u) { xcd_barrier_complete(bar, b.x, nloc, nx); b.st[0] = nloc; b.st[1] = nx; }
        const unsigned old = xb_add(&bar[XB_XSUB(b.x)], 1u);
        const unsigned gen = old / nloc;
        if (old + 1u == (gen + 1u) * nloc) {
            __builtin_amdgcn_fence(__ATOMIC_RELEASE, "agent");
            asm volatile("s_waitcnt vmcnt(0)" ::: "memory");
            const unsigned og = xb_add(&bar[XB_TOP], 1u);
            const unsigned tg = og / nx;
            if (og + 1u == (tg + 1u) * nx) xb_add(&bar[XB_TOPGEN], 1u);
            else XB_SPIN(xb_ld(&bar[XB_TOPGEN]) == tg, bar);
            __builtin_amdgcn_fence(__ATOMIC_ACQUIRE, "agent");
            xb_add(&bar[XB_XGEN(b.x)], 1u);
            asm volatile("s_waitcnt vmcnt(0)" ::: "memory");
        } else {
            XB_SPIN(xb_ld(&bar[XB_XGEN(b.x)]) == gen, bar);
            __builtin_amdgcn_fence(__ATOMIC_ACQUIRE, "agent");
            asm volatile("s_waitcnt vmcnt(0)" ::: "memory");
        }
    }
    __syncthreads();
}

enum { I_X = 0, I_MEM, I_POS, I_NORM_MIX, I_W_IN, I_LAM_RE, I_LAM_IM, I_B_RE, I_B_IM, I_C_RE, I_C_IM, I_SSM_D, I_LOG_STEP, I_W_GLU, I_Q_NORM, I_KV_NORM, I_W_UQ, I_W_UKV, I_MLA_WO,
       I_HG_LB, I_HG_GNORM, I_HG_WO, I_W_OUT, I_NORM_CROSS, I_NORM_MEM, I_XWQ, I_XWKV, I_XWO, I_NORM_FFN, I_W_GU, I_W_DOWN, I_NORM_FINAL };

constexpr int RING_BYTES = 131072, MISC_OFF = RING_BYTES + 320, LDS_BYTES = 147456;
struct Args { const float* in[32]; float* out; unsigned char* ws; int ph_lo, ph_hi; };
struct Frame {
    LAS unsigned char* lds; int tid, lane, wave, G, gw, NGW;
    const float* const* in; float* out; unsigned char* ws;
};
#define WSP(T_, off) ((T_*)(F.ws + (off)))
__device__ __forceinline__ float* ssq_ptr(const Frame& F, int l, int k) { return (float*)(F.ws + CTL_SSQ) + (size_t)ssq_idx(l, k) * T; }

__constant__ float ROPE_INVF[16] = {1.0f, 0.5623413324356079f, 0.3162277638912201f, 0.17782793939113617f, 0.10000000149011612f, 0.05623413249850273f, 0.03162277489900589f, 0.017782794311642647f,
    0.009999999776482582f, 0.005623413249850273f, 0.003162277629598975f, 0.0017782794311642647f, 0.0010000000474974513f, 0.000562341301701963f, 0.0003162277571391314f, 0.00017782794020604342f};
struct ConvTab { int in_idx, gain_idx, K, Nsrc, map, aux, layer; unsigned dst_kib; };
__constant__ ConvTab CONV_TAB[13] = {
    {I_W_IN, I_NORM_MIX, 1024, 6432, 1, 0, -1, (unsigned)(WS_WBIG >> 10)},
    {I_W_GLU, -1, 512, 2048, 0, 0, -1, (unsigned)(WS_WGLU >> 10)},
    {I_W_UQ, I_Q_NORM, 512, 768, 0, 0, -1, (unsigned)(WS_WUQ >> 10)},
    {I_W_UKV, I_KV_NORM, 256, 1024, 2, 0, -1, 0u},
    {I_MLA_WO, -1, 512, 1024, 0, 0, -1, (unsigned)(WS_WMO >> 10)},
    {I_HG_WO, -1, 512, 1024, 0, 0, -1, (unsigned)(WS_WHO >> 10)},
    {I_W_OUT, -1, 1024, 1024, 0, 0, -1, (unsigned)(WS_WOUT >> 10)},
    {I_XWQ, I_NORM_CROSS, 1024, 512, 0, 0, -1, (unsigned)(WS_WXQ >> 10)},
    {I_XWO, -1, 512, 1024, 0, 0, -1, (unsigned)(WS_WXO >> 10)},
    {I_W_GU, I_NORM_FFN, 1024, 5632, 3, 2816, -1, (unsigned)(WS_WGU >> 10)},
    {I_W_DOWN, -1, 2816, 1024, 0, 0, -1, (unsigned)(WS_WD >> 10)},
    {I_XWKV, I_NORM_MEM, 1024, 1024, 4, 0, 0, (unsigned)(WS_WXK >> 10)},
    {I_XWKV, I_NORM_MEM, 1024, 1024, 4, 0, 1, (unsigned)((WS_WXK + MiB) >> 10)},
};
__device__ __forceinline__ bf16_t* conv_dst(const Frame& F, int map, int n, int K, size_t dst_off, int aux) {
    if (map == 1) { int r; if (n < 1280) r = n; else if (n < 1312) r = 2816 + (n - 1280); else if (n < 2848) r = n - 32; else if (n < 3360) r = 3072 + (n - 2848); else r = 3584 + (n - 3360); return WSP(bf16_t, WS_WBIG) + (size_t)r * 1024; }
    if (map == 2) { const int h = n >> 7, j = n & 127; return (j < 64) ? WSP(bf16_t, WS_WUK) + (size_t)(h * 64 + j) * 256 : WSP(bf16_t, WS_WUV) + (size_t)(h * 64 + j - 64) * 256; }
    if (map == 3) { const int half = (n >= aux) ? 1 : 0, f = n - half * aux; return WSP(bf16_t, dst_off) + (size_t)((f >> 7) * 256 + half * 128 + (f & 127)) * 1024; }
    if (map == 4) { return (n < 512) ? WSP(bf16_t, dst_off) + (size_t)n * 1024 : WSP(bf16_t, dst_off + 2 * MiB) + (size_t)(n - 512) * 1024; }
    return WSP(bf16_t, dst_off) + (size_t)n * K;
}
__device__ __forceinline__ void convert_weights(const Frame& F, int l, int j0, int j1) {
    LAS float* scr = (LAS float*)(F.lds + F.wave * 16384);
    int total = 0;
    for (int j = j0; j < j1; ++j) total += (CONV_TAB[j].K / 64) * (CONV_TAB[j].Nsrc / 32);
    const int lane = F.lane;
    for (int it = F.gw; it < total; it += F.NGW) {
        int j = j0, r = it;
        for (;;) { const int c = (CONV_TAB[j].K / 64) * (CONV_TAB[j].Nsrc / 32); if (r < c) break; r -= c; ++j; }
        const int K = CONV_TAB[j].K, Nsrc = CONV_TAB[j].Nsrc, map = CONV_TAB[j].map, aux = CONV_TAB[j].aux, ll = CONV_TAB[j].layer < 0 ? l : CONV_TAB[j].layer;
        const size_t dst_off = (size_t)CONV_TAB[j].dst_kib << 10;
        const float* W = F.in[CONV_TAB[j].in_idx] + (size_t)ll * K * Nsrc; const int gi = CONV_TAB[j].gain_idx; const float* gain = F.in[gi < 0 ? 0 : gi] + (size_t)ll * K;
        const int nblk = Nsrc / 32, kb = r / nblk, nb = r % nblk, k0 = 64 * kb, n0 = 32 * nb;
#pragma unroll 4
        for (int i = 0; i < 32; ++i) { const int kk = 2 * i + (lane >> 5); float w = W[(size_t)(k0 + kk) * Nsrc + n0 + (lane & 31)]; if (gi >= 0) w *= gain[k0 + kk]; scr[kk * 33 + (lane & 31)] = w; }
        LDS_WAIT(); asm volatile("" ::: "memory");
        const int c = lane & 7;
#pragma unroll
        for (int q = 0; q < 4; ++q) { const int n = (lane >> 3) + 8 * q; const LAS float* sp = scr + (8 * c) * 33 + n;
            u32x4 o; o.x = pk2(sp[0 * 33], sp[1 * 33]); o.y = pk2(sp[2 * 33], sp[3 * 33]); o.z = pk2(sp[4 * 33], sp[5 * 33]); o.w = pk2(sp[6 * 33], sp[7 * 33]);
            *(u32x4*)(conv_dst(F, map, n0 + n, K, dst_off, aux) + k0 + 8 * c) = o; }
        LDS_WAIT(); asm volatile("" ::: "memory");
    }
}
__device__ __forceinline__ void convert_mixer_weights(const Frame& F, int l) { convert_weights(F, l, 0, 9); }
__device__ __forceinline__ void convert_ffn_weights(const Frame& F, int l) { convert_weights(F, l, 9, 11); }
__device__ __forceinline__ void prologue0(const Frame& F) {
    const float* x = F.in[I_X]; bf16_t* XB = WSP(bf16_t, WS_XB); float* ssq0 = ssq_ptr(F, 0, 0);
    for (int r = F.gw; r < T; r += F.NGW) {
        const f32x4* xr = (const f32x4*)(x + (size_t)r * DM) + F.lane; f32x4 v[4]; float s = 0.f;
#pragma unroll
        for (int j = 0; j < 4; ++j) { v[j] = xr[64 * j]; s += (v[j][0] * v[j][0] + v[j][1] * v[j][1]) + (v[j][2] * v[j][2] + v[j][3] * v[j][3]); }
        s = wave_sum(s); if (F.lane == 0) ssq0[r] = s;
        u32x2* o = (u32x2*)(XB + (size_t)r * DM) + F.lane;
#pragma unroll
        for (int j = 0; j < 4; ++j) { u32x2 w; w.x = pk2(v[j][0], v[j][1]); w.y = pk2(v[j][2], v[j][3]); o[64 * j] = w; }
    }
    const int* pos = (const int*)F.in[I_POS]; float* cosT = WSP(float, WS_COS); float* sinT = WSP(float, WS_SIN);
    for (int i = F.gw * 64 + F.lane; i < T * 16; i += F.NGW * 64) { const int r = i >> 4, j = i & 15;
        const float invf = ROPE_INVF[j];
        const float ang = (float)pos[r] * invf; float s, c; sincos_rad((double)ang, s, c); cosT[i] = c; sinT[i] = s; }
    const float* mem = F.in[I_MEM]; bf16_t* memn = WSP(bf16_t, WS_MEMN);
    for (int r = F.gw; r < NB * NMEM; r += F.NGW) {
        const f32x4* xr = (const f32x4*)(mem + (size_t)r * DM) + F.lane; f32x4 v[4]; float s = 0.f;
#pragma unroll
        for (int j = 0; j < 4; ++j) { v[j] = xr[64 * j]; s += (v[j][0] * v[j][0] + v[j][1] * v[j][1]) + (v[j][2] * v[j][2] + v[j][3] * v[j][3]); }
        const float rs = rstd_of(wave_sum(s), 1.f / DM);
        u32x2* o = (u32x2*)(memn + (size_t)r * DM) + F.lane;
#pragma unroll
        for (int j = 0; j < 4; ++j) { u32x2 w; w.x = pk2(v[j][0] * rs, v[j][1] * rs); w.y = pk2(v[j][2] * rs, v[j][3] * rs); o[64 * j] = w; }
    }
    convert_weights(F, 0, 11, 13);
}

__device__ __forceinline__ void naive_s5(const Frame& F, int l) {
    if (F.wave != 0 || blockIdx.x >= NB * 32) return;
    const int b = blockIdx.x >> 5, g = blockIdx.x & 31, p = F.lane;
    LAS float* cre = (LAS float*)F.lds; LAS float* cim = cre + 1024; LAS float* xs = cim + 1024;
    const float* c_re = F.in[I_C_RE] + ((size_t)l * 32 + g) * 1024; const float* c_im = F.in[I_C_IM] + ((size_t)l * 32 + g) * 1024;
    for (int i = p; i < 1024; i += 64) { cre[i] = c_re[i]; cim[i] = c_im[i]; }
    const float step = __expf(F.in[I_LOG_STEP][l * 32 + g]);
    const float lr = F.in[I_LAM_RE][(l * 32 + g) * 64 + p], li = F.in[I_LAM_IM][(l * 32 + g) * 64 + p];
    float sn, cs; sincos_rad((double)li * (double)step, sn, cs); const float mag = __expf(lr * step); const float lbr = mag * cs, lbi = mag * sn;
    const float den = 1.f / (lr * lr + li * li); const float nr = lbr - 1.f, ni = lbi; const float cfr = (nr * lr + ni * li) * den, cfi = (ni * lr - nr * li) * den;
    float bbr[16], bbi[16];
    const float* b_re = F.in[I_B_RE] + (((size_t)l * 32 + g) * 64 + p) * 16; const float* b_im = F.in[I_B_IM] + (((size_t)l * 32 + g) * 64 + p) * 16;
#pragma unroll
    for (int h = 0; h < 16; ++h) { const float br = b_re[h], bi = b_im[h]; bbr[h] = cfr * br - cfi * bi; bbi[h] = cfr * bi + cfi * br; }
    const float dsk = (p < 16) ? F.in[I_SSM_D][(l * 32 + g) * 16 + p] : 0.f;
    const bf16_t* Up = WSP(bf16_t, WS_UP) + (size_t)g * 256 * 1024; bf16_t* YS = WSP(bf16_t, WS_YS);
    float xr = 0.f, xi = 0.f; LDS_WAIT();
    for (int t = 0; t < SEQ; ++t) {
        const int ch = b * 64 + (t >> 6), s = t & 63;
        const u32x4* up = (const u32x4*)(Up + (size_t)ch * 1024 + s * 16); f32x4 u0, u1, u2, u3; unpack8(up[0], u0, u1); unpack8(up[1], u2, u3);
        float ur = 0.f, ui = 0.f;
#pragma unroll
        for (int h = 0; h < 4; ++h) { ur += bbr[h] * u0[h] + bbr[4 + h] * u1[h] + bbr[8 + h] * u2[h] + bbr[12 + h] * u3[h]; ui += bbi[h] * u0[h] + bbi[4 + h] * u1[h] + bbi[8 + h] * u2[h] + bbi[12 + h] * u3[h]; }
        const float nxr = lbr * xr - lbi * xi + ur, nxi = lbr * xi + lbi * xr + ui; xr = nxr; xi = nxi;
        xs[p] = xr; xs[64 + p] = xi; LDS_WAIT(); __builtin_amdgcn_wave_barrier();
        if (p < 16) { float y = 0.f;
#pragma unroll 8
            for (int q = 0; q < 64; ++q) y += cre[p * 64 + q] * xs[q] - cim[p * 64 + q] * xs[64 + q];
            const float uu = (p < 4) ? u0[p & 3] : (p < 8) ? u1[p & 3] : (p < 12) ? u2[p & 3] : u3[p & 3];
            y = geluf_(y + dsk * uu);
            YS[(size_t)(b * SEQ + t) * 512 + g * 16 + p] = (bf16_t)(pk2(y, 0.f) & 0xffffu); }
        LDS_WAIT(); __builtin_amdgcn_wave_barrier();
    }
}

__device__ __forceinline__ void naive_hgrn(const Frame& F, int l) {
    if (blockIdx.x >= NB * 4) return;
    const int b = blockIdx.x >> 2, h = blockIdx.x & 3, tid = F.tid, e = tid & 127, dq = tid >> 7;
    LAS float* qf = (LAS float*)F.lds; LAS float* ff = qf + 128; LAS float* kk = ff + 128; LAS float* part = kk + 128; LAS float* ob = part + 512;
    float lb = 0.f;
    if (l == 1) { const float a0 = F.in[I_HG_LB][h * 128 + e], a1 = F.in[I_HG_LB][512 + h * 128 + e]; const float mx = fmaxf(a0, a1); const float e0 = __expf(a0 - mx), e1 = __expf(a1 - mx); lb = e1 / (e0 + e1); }
    const float gn = F.in[I_HG_GNORM][l * 128 + e];
    bf16_t* HGQ = WSP(bf16_t, WS_HGQ); const _Float16* HGXF = WSP(_Float16, WS_HGXF); const bf16_t* HGI = WSP(bf16_t, WS_HGI); const bf16_t* HGSG = WSP(bf16_t, WS_HGSG);
    float Sreg[32];
#pragma unroll
    for (int d = 0; d < 32; ++d) Sreg[d] = 0.f;
    for (int t = 0; t < SEQ; ++t) {
        const size_t ro = (size_t)(b * SEQ + t) * 512 + h * 128;
        if (dq == 0) { const float xf = (float)HGXF[ro + e]; const float sg = sigmoidf_(xf); qf[e] = bf2f(HGQ[ro + e]); ff[e] = lb + (1.f - lb) * sg; kk[e] = (1.f - lb) * (1.f - sg); }
        const float v = bf2f(HGI[ro + e]);
        __syncthreads();
        float po = 0.f;
#pragma unroll
        for (int d = 0; d < 32; ++d) { const int dd = dq * 32 + d; Sreg[d] = ff[dd] * Sreg[d] + kk[dd] * v; po += qf[dd] * Sreg[d]; }
        part[dq * 128 + e] = po;
        __syncthreads();
        float o = 0.f;
        if (dq == 0) { o = (part[e] + part[128 + e]) + (part[256 + e] + part[384 + e]); ob[e] = o; }
        __syncthreads();
        if (dq == 0) { float ss = 0.f;
#pragma unroll 8
            for (int j = 0; j < 128; ++j) ss += ob[j] * ob[j];
            const float y = o * rstd_of(ss, 1.f / 128) * gn * bf2f(HGSG[ro + e]);
            HGQ[ro + e] = (bf16_t)(pk2(y, 0.f) & 0xffffu); }
    }
}

__device__ __forceinline__ void naive_attn(const Frame& F) {
    const int gt = blockIdx.x * NTHREADS + F.tid; const int h = gt >> 14, tok = gt & (T - 1), b = tok >> 12, tl = tok & (SEQ - 1);
    bf16_t* Q = WSP(bf16_t, WS_Q); const bf16_t* KN = WSP(bf16_t, WS_QLAT); const bf16_t* KPE = WSP(bf16_t, WS_KPE); const bf16_t* VT = WSP(bf16_t, WS_UP);
    u32x4 qp[12];
#pragma unroll
    for (int i = 0; i < 12; ++i) qp[i] = *(const u32x4*)(Q + (size_t)tok * 768 + h * 96 + i * 8);
    float acc[64];
#pragma unroll
    for (int d = 0; d < 64; ++d) acc[d] = 0.f;
    float mrun = -1e30f, lrun = 0.f;
    const int tmax = __builtin_amdgcn_readfirstlane(((blockIdx.x * NTHREADS + (F.tid | 63)) & (SEQ - 1)));
    for (int s0 = 0; s0 <= tmax; s0 += 8) {
        float sc[8];
#pragma unroll
        for (int j = 0; j < 8; ++j) { const size_t kr = (size_t)(b * SEQ + s0 + j); float s = 0.f;
#pragma unroll
            for (int i = 0; i < 8; ++i) { f32x4 k0, k1, q0, q1; unpack8(*(const u32x4*)(KN + kr * 512 + h * 64 + i * 8), k0, k1); unpack8(qp[i], q0, q1);
                s += (q0[0] * k0[0] + q0[1] * k0[1]) + (q0[2] * k0[2] + q0[3] * k0[3]) + (q1[0] * k1[0] + q1[1] * k1[1]) + (q1[2] * k1[2] + q1[3] * k1[3]); }
#pragma unroll
            for (int i = 0; i < 4; ++i) { f32x4 k0, k1, q0, q1; unpack8(*(const u32x4*)(KPE + kr * 32 + i * 8), k0, k1); unpack8(qp[8 + i], q0, q1);
                s += (q0[0] * k0[0] + q0[1] * k0[1]) + (q0[2] * k0[2] + q0[3] * k0[3]) + (q1[0] * k1[0] + q1[1] * k1[1]) + (q1[2] * k1[2] + q1[3] * k1[3]); }
            sc[j] = (s0 + j <= tl) ? s : -1e30f; }
        float mx = mrun;
#pragma unroll
        for (int j = 0; j < 8; ++j) mx = fmaxf(mx, sc[j]);
        const float f = fexp2(mrun - mx); mrun = mx; lrun *= f;
#pragma unroll
        for (int j = 0; j < 8; ++j) { sc[j] = (s0 + j <= tl) ? fexp2(sc[j] - mx) : 0.f; lrun += sc[j]; }
#pragma unroll
        for (int d = 0; d < 64; ++d) { f32x4 v0, v1; unpack8(*(const u32x4*)(VT + (size_t)(h * 64 + d) * T + b * SEQ + s0), v0, v1);
            acc[d] = acc[d] * f + (sc[0] * v0[0] + sc[1] * v0[1]) + (sc[2] * v0[2] + sc[3] * v0[3]) + (sc[4] * v1[0] + sc[5] * v1[1]) + (sc[6] * v1[2] + sc[7] * v1[3]); }
    }
    const float il = 1.f / lrun;
#pragma unroll
    for (int d = 0; d < 64; d += 8) { f32x4 a, c2; _Pragma("unroll") for (int i = 0; i < 4; ++i) { a[i] = acc[d + i] * il; c2[i] = acc[d + 4 + i] * il; }
        *(u32x4*)(Q + (size_t)tok * 768 + h * 96 + d) = pack8(a, c2); }
}
__device__ __forceinline__ void naive_xattn(const Frame& F, int l) {
  for (int pass = 0; pass < 2; ++pass) {
    const int gt = (pass * F.G + blockIdx.x) * NTHREADS + F.tid; const int hv = gt >> 14, tok = gt & (T - 1), b = tok >> 12, h = hv >> 2, vq = hv & 3;
    const bf16_t* QX = WSP(bf16_t, WS_QX); bf16_t* OX = WSP(bf16_t, WS_OX); const bf16_t* MK = WSP(bf16_t, WS_MEMK + (size_t)l * MiB); const bf16_t* MVT = WSP(bf16_t, WS_MEMVT + (size_t)l * MiB);
    float acc[32];
#pragma unroll
    for (int d = 0; d < 32; ++d) acc[d] = 0.f;
    float mrun = -1e30f, lrun = 0.f;
    for (int s0 = 0; s0 < NMEM; s0 += 8) {
        float sc[8];
#pragma unroll
        for (int j = 0; j < 8; ++j) { const size_t kr = (size_t)(b * NMEM + s0 + j); float s = 0.f;
#pragma unroll 4
            for (int i = 0; i < 16; ++i) { f32x4 k0, k1, q0, q1; unpack8(*(const u32x4*)(MK + kr * 512 + h * 128 + i * 8), k0, k1); unpack8(*(const u32x4*)(QX + (size_t)tok * 512 + h * 128 + i * 8), q0, q1);
                s += (q0[0] * k0[0] + q0[1] * k0[1]) + (q0[2] * k0[2] + q0[3] * k0[3]) + (q1[0] * k1[0] + q1[1] * k1[1]) + (q1[2] * k1[2] + q1[3] * k1[3]); }
            sc[j] = s; }
        float mx = mrun;
#pragma unroll
        for (int j = 0; j < 8; ++j) mx = fmaxf(mx, sc[j]);
        const float f = fexp2(mrun - mx); mrun = mx; lrun *= f;
#pragma unroll
        for (int j = 0; j < 8; ++j) { sc[j] = fexp2(sc[j] - mx); lrun += sc[j]; }
#pragma unroll
        for (int d = 0; d < 32; ++d) { f32x4 v0, v1; unpack8(*(const u32x4*)(MVT + (size_t)(h * 128 + vq * 32 + d) * (NB * NMEM) + b * NMEM + s0), v0, v1);
            acc[d] = acc[d] * f + (sc[0] * v0[0] + sc[1] * v0[1]) + (sc[2] * v0[2] + sc[3] * v0[3]) + (sc[4] * v1[0] + sc[5] * v1[1]) + (sc[6] * v1[2] + sc[7] * v1[3]); }
    }
    const float il = 1.f / lrun;
#pragma unroll
    for (int d = 0; d < 32; d += 8) { f32x4 a, c2; _Pragma("unroll") for (int i = 0; i < 4; ++i) { a[i] = acc[d + i] * il; c2[i] = acc[d + 4 + i] * il; }
        *(u32x4*)(OX + (size_t)tok * 512 + h * 128 + vq * 32 + d) = pack8(a, c2); }
  }
}
__device__ __forceinline__ void final_norm(const Frame& F) {
    const float* ssq = ssq_ptr(F, 2, 0); const float* gw_ = F.in[I_NORM_FINAL];
    for (int r = F.gw; r < T; r += F.NGW) { const float rs = rstd_of(ssq[r], 1.f / DM); f32x4* xr = (f32x4*)(F.out + (size_t)r * DM) + F.lane;
#pragma unroll
        for (int j = 0; j < 4; ++j) { const f32x4 g = *((const f32x4*)gw_ + F.lane + 64 * j); xr[64 * j] = xr[64 * j] * rs * g; } }
}

constexpr int NP = 13;
constexpr int NPH = NL * NP + 1;
#define GEMM_RUN(EPI_T, E_, g_) do { pg8::StaticOrder S_; S_.init((g_).nM, (g_).nN, F.G, (int)blockIdx.x); int t_ = F.tid; asm volatile("" : "+v"(t_)); pg8::gemm_phase<EPI_T>(F.lds, t_, (g_), S_, (E_)); } while (0)

template <unsigned PHM> __global__ void __launch_bounds__(NTHREADS, 2) mk_fwd(Args args) {
    extern __shared__ __attribute__((aligned(16))) unsigned char lds_raw[];
    { LAS unsigned* z = (LAS unsigned*)((LAS unsigned char*)lds_raw + RING_BYTES); for (int u = threadIdx.x; u < (LDS_BYTES - RING_BYTES) / 4; u += NTHREADS) z[u] = 0u; }
    __syncthreads();
    unsigned* ctl = (unsigned*)(args.ws + WS_CTL);
    XcdBarrier bar; bar.bar = ctl + CW_BAR; bar.x = 0; bar.st = nullptr;
    const bool one_launch = (args.ph_hi - args.ph_lo) > 1;
    if (one_launch) bar = xcd_barrier_post(ctl + CW_BAR, (volatile LAS unsigned*)((LAS unsigned char*)lds_raw + MISC_OFF) + 8);

    for (int ph = args.ph_lo; ph < args.ph_hi; ++ph) {
        const int l = ph / NP, p = (ph < NL * NP) ? ph % NP : NP;
        int tid_ = threadIdx.x; asm volatile("" : "+v"(tid_));
        int oz = 0; asm volatile("" : "+v"(oz)); oz = __builtin_amdgcn_readfirstlane(oz);
        unsigned char* ws_ = args.ws + oz; const float* const* in_ = args.in + oz; float* out_ = args.out + oz;
        Frame F; F.lds = (LAS unsigned char*)lds_raw; F.tid = tid_; F.lane = F.tid & 63; F.wave = __builtin_amdgcn_readfirstlane(F.tid >> 6); F.G = gridDim.x;
        F.gw = blockIdx.x * NWAVES + F.wave; F.NGW = F.G * NWAVES; F.in = in_; F.out = out_; F.ws = ws_;
        float* const cosT = WSP(float, WS_COS); float* const sinT = WSP(float, WS_SIN);
        const bf16_t* const XB = WSP(bf16_t, WS_XB); const bf16_t* const WBIG = WSP(bf16_t, WS_WBIG);
#define PH_ON(k) (((PHM) >> (k)) & 1u)
        switch (p) {
        case 0: if (PH_ON(0)) {
            if (l == 0) prologue0(F);
            convert_mixer_weights(F, l);
        } break;
        case 1: if (PH_ON(1)) {
            { pg8::Gemm g = pg8::mk(XB, DM, WBIG, DM, T, 3072, DM);
              EpiInProj E{F.ws, l};
              GEMM_RUN(EpiInProj, E, g); }
            if (l == 0) for (int ll = 0; ll < NL; ++ll) {
                { pg8::Gemm g = pg8::mk(WSP(bf16_t, WS_MEMN), DM, WSP(bf16_t, WS_WXK + (size_t)ll * MiB), DM, NB * NMEM, 512, DM);
                  EpiRowBf16<0> E{nullptr, 0.f, 1.f, WSP(bf16_t, WS_MEMK + (size_t)ll * MiB), 512}; GEMM_RUN(EpiRowBf16<0>, E, g); }
                { pg8::Gemm g = pg8::mk(WSP(bf16_t, WS_WXV + (size_t)ll * MiB), DM, WSP(bf16_t, WS_MEMN), DM, 512, NB * NMEM, DM);
                  EpiRowBf16<0> E{nullptr, 0.f, 1.f, WSP(bf16_t, WS_MEMVT + (size_t)ll * MiB), NB * NMEM}; GEMM_RUN(EpiRowBf16<0>, E, g); }
            }
        } break;
        case 2: if (PH_ON(2)) {
            { pg8::Gemm g = pg8::mk(WSP(bf16_t, WS_QLAT), 512, WSP(bf16_t, WS_WUQ), 512, T, 768, 512);
              EpiQ E{ssq_ptr(F, l, 1), WSP(bf16_t, WS_Q), cosT, sinT, 0.10206207261596577f * LOG2E}; GEMM_RUN(EpiQ, E, g); }
            naive_s5(F, l);
        } break;
        case 3: if (PH_ON(3)) {
            { pg8::Gemm g = pg8::mk(WSP(bf16_t, WS_KVLAT), 256, WSP(bf16_t, WS_WUK), 256, T, 512, 256);
              EpiRowBf16<0> E{ssq_ptr(F, l, 2), 1.f / 256, 1.f, WSP(bf16_t, WS_QLAT), 512}; GEMM_RUN(EpiRowBf16<0>, E, g); }
            { pg8::Gemm g = pg8::mk(WSP(bf16_t, WS_WUV), 256, WSP(bf16_t, WS_KVLAT), 256, 512, T, 256);
              EpiColBf16 E{ssq_ptr(F, l, 2), 1.f / 256, WSP(bf16_t, WS_UP), T}; GEMM_RUN(EpiColBf16, E, g); }
            { pg8::Gemm g = pg8::mk(XB, DM, WBIG + (size_t)3072 * DM, DM, T, 512, DM);
              EpiRowBf16<1> E{ssq_ptr(F, l, 0), 1.f / DM, 1.f, WSP(bf16_t, WS_HGSG), 512}; GEMM_RUN(EpiRowBf16<1>, E, g); }
        } break;
        case 4: if (PH_ON(4)) {
            naive_attn(F);
            naive_hgrn(F, l);
        } break;
        case 5: break;
        case 6: if (PH_ON(6)) {
            const bf16_t* WG = WBIG + (size_t)3584 * DM; bf16_t* GT = WSP(bf16_t, WS_GT); bf16_t* ZT = WSP(bf16_t, WS_ZT); bf16_t* MG = WSP(bf16_t, WS_MG);
            { pg8::Gemm g = pg8::mk(XB, DM, WG, DM, T, 1024, DM); EpiRowBf16<2> E{ssq_ptr(F, l, 0), 1.f / DM, 1.f, GT, 1024}; GEMM_RUN(EpiRowBf16<2>, E, g); }
            { pg8::Gemm g = pg8::mk(WSP(bf16_t, WS_YS), 512, WSP(bf16_t, WS_WGLU), 512, T, 1024, 512); EpiRowBf16<0> E{nullptr, 0.f, 1.f, ZT, 1024}; GEMM_RUN(EpiRowBf16<0>, E, g); }
            { pg8::Gemm g = pg8::mk(WSP(bf16_t, WS_YS), 512, WSP(bf16_t, WS_WGLU) + (size_t)1024 * 512, 512, T, 1024, 512); EpiMerge<0> E{GT, ZT, MG}; GEMM_RUN(EpiMerge<0>, E, g); }
            { pg8::Gemm g = pg8::mk(XB, DM, WG + (size_t)1024 * DM, DM, T, 1024, DM); EpiRowBf16<2> E{ssq_ptr(F, l, 0), 1.f / DM, 1.f, GT, 1024}; GEMM_RUN(EpiRowBf16<2>, E, g); }
            { pg8::Gemm g = pg8::mk(WSP(bf16_t, WS_Q), 768, WSP(bf16_t, WS_WMO), 512, T, 1024, 512); g.kstepA = 96 * 2; EpiMerge<1> E{GT, ZT, MG}; GEMM_RUN(EpiMerge<1>, E, g); }
            { pg8::Gemm g = pg8::mk(XB, DM, WG + (size_t)2048 * DM, DM, T, 1024, DM); EpiRowBf16<2> E{ssq_ptr(F, l, 0), 1.f / DM, 1.f, GT, 1024}; GEMM_RUN(EpiRowBf16<2>, E, g); }
            { pg8::Gemm g = pg8::mk(WSP(bf16_t, WS_HGQ), 512, WSP(bf16_t, WS_WHO), 512, T, 1024, 512); EpiMerge<1> E{GT, ZT, MG}; GEMM_RUN(EpiMerge<1>, E, g); }
        } break;
        case 7: if (PH_ON(7)) {
            pg8::Gemm g = pg8::mk(WSP(bf16_t, WS_MG), DM, WSP(bf16_t, WS_WOUT), DM, T, 1024, DM);
            EpiResid E{l == 0 ? F.in[I_X] : F.out, F.out, WSP(bf16_t, WS_XB), ssq_ptr(F, l, 3)}; GEMM_RUN(EpiResid, E, g);
        } break;
        case 8: if (PH_ON(8)) {
            pg8::Gemm g = pg8::mk(XB, DM, WSP(bf16_t, WS_WXQ), DM, T, 512, DM);
            EpiRowBf16<0> E{ssq_ptr(F, l, 3), 1.f / DM, 0.08838834764831845f * LOG2E, WSP(bf16_t, WS_QX), 512}; GEMM_RUN(EpiRowBf16<0>, E, g);
        } break;
        case 9: if (PH_ON(9)) {
            naive_xattn(F, l);
            convert_ffn_weights(F, l);
        } break;
        case 10: if (PH_ON(10)) {
            pg8::Gemm g = pg8::mk(WSP(bf16_t, WS_OX), 512, WSP(bf16_t, WS_WXO), 512, T, 1024, 512);
            EpiResid E{F.out, F.out, WSP(bf16_t, WS_XB), ssq_ptr(F, l, 4)}; GEMM_RUN(EpiResid, E, g);
        } break;
        case 11: if (PH_ON(11)) {
            pg8::Gemm g = pg8::mk(XB, DM, WSP(bf16_t, WS_WGU), DM, T, 2 * DFF, DM);
            EpiSwiGLU E{ssq_ptr(F, l, 4), WSP(bf16_t, WS_H)}; GEMM_RUN(EpiSwiGLU, E, g);
        } break;
        case 12: if (PH_ON(12)) {
            pg8::Gemm g = pg8::mk(WSP(bf16_t, WS_H), DFF, WSP(bf16_t, WS_WD), DFF, T, 1024, DFF);
            EpiResid E{F.out, F.out, WSP(bf16_t, WS_XB), ssq_ptr(F, l + 1, 0)}; GEMM_RUN(EpiResid, E, g);
        } break;
        case 13: if (PH_ON(13)) final_norm(F); break;
        default: break;
        }
        if (ph + 1 < args.ph_hi) xcd_barrier(bar);
    }
}

typedef void (*KernFn)(Args);
template <unsigned PHM> static void launch_one(int grid, hipStream_t stream, const Args& a) { hipLaunchKernelGGL(mk_fwd<PHM>, dim3(grid), dim3(NTHREADS), LDS_BYTES, stream, a); }
template <unsigned PHM> static bool prep_one() { return hipFuncSetAttribute((const void*)mk_fwd<PHM>, hipFuncAttributeMaxDynamicSharedMemorySize, LDS_BYTES) == hipSuccess; }
extern "C" void kernel_launch(void* const* d_in, const int* in_sizes, int n_in, void* d_out, int out_size, void* d_ws, size_t ws_size, hipStream_t stream) {
    static int grid = 0;
    if (grid == 0) {
        if (n_in != 32 || out_size != T * DM || ws_size < WS_END) { fprintf(stderr, "kernel_launch: unexpected shapes (n_in %d out %d ws %zu)\n", n_in, out_size, ws_size); grid = -1; return; }
        int dev = 0, cus = 0;
        if (hipGetDevice(&dev) != hipSuccess || hipDeviceGetAttribute(&cus, hipDeviceAttributeMultiprocessorCount, dev) != hipSuccess) { grid = -1; return; }
        bool ok = true;
#if MK_MULTI
        ok = ok && prep_one<1u << 0>() && prep_one<1u << 1>() && prep_one<1u << 2>() && prep_one<1u << 3>() && prep_one<1u << 4>() && prep_one<1u << 6>() && prep_one<1u << 7>() && prep_one<1u << 8>()
                && prep_one<1u << 9>() && prep_one<1u << 10>() && prep_one<1u << 11>() && prep_one<1u << 12>() && prep_one<1u << 13>();
#else
        ok = ok && prep_one<0xFFFFu>();
#endif
        if (!ok) { fprintf(stderr, "kernel_launch: hipFuncSetAttribute failed\n"); grid = -1; return; }
        grid = cus;
        if (grid != 256) fprintf(stderr, "kernel_launch: %d CUs (expected 256)\n", grid);
    }
    if (grid < 0) return;
    (void)hipMemsetAsync((char*)d_ws + WS_CTL, 0, CTL_BYTES, stream);
    Args a{};
    for (int i = 0; i < 32; ++i) a.in[i] = (const float*)d_in[i];
    a.out = (float*)d_out; a.ws = (unsigned char*)d_ws;
#if MK_MULTI
    for (int ph = 0; ph < NPH; ++ph) { a.ph_lo = ph; a.ph_hi = ph + 1; const int p = (ph < NL * NP) ? ph % NP : NP;
        switch (p) {
        case 0: launch_one<1u << 0>(grid, stream, a); break; case 1: launch_one<1u << 1>(grid, stream, a); break; case 2: launch_one<1u << 2>(grid, stream, a); break;
        case 3: launch_one<1u << 3>(grid, stream, a); break; case 4: launch_one<1u << 4>(grid, stream, a); break; case 5: break;
        case 6: launch_one<1u << 6>(grid, stream, a); break; case 7: launch_one<1u << 7>(grid, stream, a); break; case 8: launch_one<1u << 8>(grid, stream, a); break;
        case 9: launch_one<1u << 9>(grid, stream, a); break; case 10: launch_one<1u << 10>(grid, stream, a); break; case 11: launch_one<1u << 11>(grid, stream, a); break;
        case 12: launch_one<1u << 12>(grid, stream, a); break; default: launch_one<1u << 13>(grid, stream, a); break; } }
#else
    a.ph_lo = 0; a.ph_hi = NPH; launch_one<0xFFFFu>(grid, stream, a);
#endif
}
```

```cpp
#include <hip/hip_runtime.h>
#include <cstdio>
#include <cstdint>

#ifndef MK_MULTI
#define MK_MULTI 0
#endif

#define LAS __attribute__((address_space(3)))
#define GAS __attribute__((address_space(1)))
typedef unsigned short bf16_t;
typedef short bf16x8 __attribute__((ext_vector_type(8)));
typedef float f32x4 __attribute__((ext_vector_type(4)));
typedef float f32x2 __attribute__((ext_vector_type(2)));
typedef unsigned u32x4 __attribute__((ext_vector_type(4)));
typedef unsigned u32x2 __attribute__((ext_vector_type(2)));
typedef __bf16 bf16x2_t __attribute__((ext_vector_type(2)));
typedef float f32x16 __attribute__((ext_vector_type(16)));
__device__ __forceinline__ int crow16(int r, int hi) { return (r & 3) + 8 * (r >> 2) + 4 * hi; }

constexpr int NB = 4, SEQ = 4096, T = NB * SEQ, DM = 1024, NL = 2, NMEM = 256;
constexpr int DIN = 6432, DFF = 2816;
constexpr float RMS_EPS = 1e-6f;
constexpr float LOG2E = 1.4426950408889634f;
constexpr int NWAVES = 8, NTHREADS = 512;

constexpr size_t MiB = 1u << 20;
constexpr size_t WS_CTL = 0, CTL_BYTES = 1 * MiB;
constexpr size_t WS_COS = 1 * MiB, WS_SIN = 2 * MiB;
constexpr size_t WS_MEMK = 3 * MiB, WS_MEMVT = 5 * MiB;
constexpr size_t WS_TOEP = 7 * MiB, WS_BMAT = 9 * MiB, WS_CMAT = 17 * MiB;
constexpr size_t WS_WBIG = 26 * MiB;
constexpr size_t WS_WGLU = 39 * MiB, WS_WUQ = 41 * MiB, WS_WUK = 42 * MiB, WS_WUV = 42 * MiB + 512 * 1024;
constexpr size_t WS_WMO = 43 * MiB, WS_WHO = 44 * MiB, WS_WOUT = 45 * MiB, WS_WXQ = 47 * MiB, WS_WXO = 48 * MiB;
constexpr size_t WS_SUMS = 49 * MiB, WS_XST = 53 * MiB, WS_HGDEC = 57 * MiB;
constexpr size_t WS_XB = 58 * MiB;
constexpr size_t WS_HGQ = 90 * MiB;
constexpr size_t WS_Q = 106 * MiB;
constexpr size_t WS_YS = 130 * MiB;
constexpr size_t WS_UP = 146 * MiB;
constexpr size_t WS_QLAT = 162 * MiB;
constexpr size_t WS_KVLAT = 178 * MiB;
constexpr size_t WS_KPE = 186 * MiB;
constexpr size_t WS_HGXF = 187 * MiB;
constexpr size_t WS_HGI = 203 * MiB;
constexpr size_t WS_HGSG = 219 * MiB;
constexpr size_t WS_HGUS = 235 * MiB;
constexpr size_t WS_GT = 146 * MiB, WS_ZT = 178 * MiB, WS_MG = 210 * MiB;
constexpr size_t WS_QX = 90 * MiB, WS_OX = 106 * MiB, WS_WGU = 122 * MiB, WS_WD = 133 * MiB;
constexpr size_t WS_H = 146 * MiB;
constexpr size_t WS_MEMN = 235 * MiB, WS_WXK = 237 * MiB, WS_WXV = 239 * MiB;
constexpr size_t WS_END = 256 * MiB;
constexpr int CW_TMO = 0, CW_BAR = 4096;
constexpr size_t CTL_SSQ = 64 * 1024;
__host__ __device__ constexpr int ssq_idx(int l, int k) { return l * 5 + k; }

__device__ __forceinline__ float bf2f(unsigned h) { return __uint_as_float(h << 16); }
__device__ __forceinline__ unsigned pk2(float lo, float hi) { f32x2 v = {lo, hi}; bf16x2_t b = __builtin_convertvector(v, bf16x2_t); return __builtin_bit_cast(unsigned, b); }
__device__ __forceinline__ u32x4 pack8(const f32x4 a, const f32x4 b) { u32x4 w; w.x = pk2(a[0], a[1]); w.y = pk2(a[2], a[3]); w.z = pk2(b[0], b[1]); w.w = pk2(b[2], b[3]); return w; }
__device__ __forceinline__ void unpack8(const u32x4 w, f32x4& a, f32x4& b) {
    a[0] = __uint_as_float(w.x << 16); a[1] = __uint_as_float(w.x & 0xffff0000u); a[2] = __uint_as_float(w.y << 16); a[3] = __uint_as_float(w.y & 0xffff0000u);
    b[0] = __uint_as_float(w.z << 16); b[1] = __uint_as_float(w.z & 0xffff0000u); b[2] = __uint_as_float(w.w << 16); b[3] = __uint_as_float(w.w & 0xffff0000u); }
__device__ __forceinline__ float fexp2(float x) { return __builtin_amdgcn_exp2f(x); }
__device__ __forceinline__ float frcp(float x) { return __builtin_amdgcn_rcpf(x); }
__device__ __forceinline__ float sigmoidf_(float x) { return frcp(1.f + fexp2(-x * LOG2E)); }
__device__ __forceinline__ float siluf_(float x) { return x * sigmoidf_(x); }
__device__ __forceinline__ float geluf_(float x) { const float u = 0.7978845608028654f * (x + 0.044715f * x * x * x); return x * frcp(1.f + fexp2(-2.f * LOG2E * u)); }
__device__ __forceinline__ float rstd_of(float ssq, float inv_n) { return __builtin_amdgcn_rsqf(ssq * inv_n + RMS_EPS); }
__device__ __forceinline__ float wave_sum(float v) {
#pragma unroll
    for (int o = 1; o < 64; o <<= 1) v += __shfl_xor(v, o);
    return v;
}
__device__ __forceinline__ void sincos_rad(double a, float& s, float& c) {
    double rev = a * 0.15915494309189533576888; rev -= __builtin_rint(rev); const float fr = (float)rev;
    s = __builtin_amdgcn_sinf(fr); c = __builtin_amdgcn_cosf(fr);
}
#define LDS_WAIT() asm volatile("s_waitcnt lgkmcnt(0)" ::: "memory")
#define VM_WAIT() asm volatile("s_waitcnt vmcnt(0)" ::: "memory")

namespace pg8 {
constexpr int BM = 256, BK = 64, HALF = 128, HTB = HALF * BK * 2, STAGE_BYTES = 8 * HTB, NXCD = 8, WGM = 8;
__host__ __device__ __forceinline__ int lds_byte(int r, int c) { const int st = (r >> 4) * 2 + (c >> 5), rr = r & 15, cc = c & 31, ob = rr * 64 + cc * 2; return st * 1024 + (ob ^ (((ob >> 9) & 1) << 5)); }
__host__ __device__ __forceinline__ void stage_rc(int b, int& R, int& C) { const int st = b / 1024, sb = b % 1024, swz = sb ^ (((sb >> 9) & 1) << 5); R = (st >> 1) * 16 + swz / 64; C = (st & 1) * 32 + (swz % 64) / 2; }
__host__ __device__ __forceinline__ int perm32(int rho) { const int n = rho >> 4, i = rho & 15; return 8 * (i >> 2) + 4 * n + (i & 3); }

struct Unit { int pm, pn; };
struct Gemm {
    const char* A; const char* Bt; int nM, nN, K;
    int rsA, c16A; long kstepA, hstepA, tstepA;
    int rsB, c16B, offB; long kstepB, hstepB, tstepB, zstepB;
};
__device__ __forceinline__ Gemm mk(const bf16_t* A, int lda, const bf16_t* Bt, int ldb, int M, int N, int K) {
    Gemm g; g.A = (const char*)A; g.Bt = (const char*)Bt; g.nM = M / BM; g.nN = N / BM; g.K = K;
    g.rsA = lda * 2; g.c16A = 32; g.kstepA = BK * 2; g.hstepA = (long)HALF * lda * 2; g.tstepA = 2 * g.hstepA;
    g.rsB = ldb * 2; g.c16B = 32; g.offB = 0; g.kstepB = BK * 2; g.hstepB = (long)HALF * ldb * 2; g.tstepB = 2 * g.hstepB; g.zstepB = 0;
    return g;
}
struct StaticOrder {
    int nM, nN, nwg, G, c;
    __device__ __forceinline__ void init(int nM_, int nN_, int G_, int c_) { nM = nM_; nN = nN_; nwg = nM * nN; G = G_; c = c_; }
    __device__ __forceinline__ bool next(int i, Unit& u) const {
        const long L = (long)i * G + c; if (L >= nwg) return false;
        int wgid = (int)L; { const int q = nwg / NXCD, r = nwg % NXCD, xcd = wgid % NXCD, off = wgid / NXCD; wgid = (xcd < r ? xcd * (q + 1) : r * (q + 1) + (xcd - r) * q) + off; }
        const int nig = WGM * nN, gid = wgid / nig, fm = gid * WGM, gsz = (nM - fm) < WGM ? (nM - fm) : WGM;
        u.pm = fm + ((wgid % nig) % gsz); u.pn = (wgid % nig) / gsz; return true;
    }
};

template <class Epi>
__device__ __forceinline__ void gemm_phase(LAS unsigned char* lds, const int tid, const Gemm g, const StaticOrder& S, const Epi& E) {
    const int wid = __builtin_amdgcn_readfirstlane(tid >> 6), lane = tid & 63, wr = wid >> 2, wc = wid & 3, fr = lane & 15, fq = lane >> 4;
    const int nt = g.K / BK;
    unsigned voffA[2], voffB[2];
#pragma unroll
    for (int i = 0; i < 2; ++i) { int R, C; stage_rc(tid * 16 + i * 8192, R, C); const int Rb = (R & ~31) + perm32(R & 31);
        voffA[i] = (unsigned)(R * g.rsA + (C >> 4) * g.c16A + (C & 15) * 2); voffB[i] = (unsigned)(g.offB + Rb * g.rsB + (C >> 4) * g.c16B + (C & 15) * 2); }
    const long kstepA = g.kstepA, kstepB = g.kstepB, hstepA = g.hstepA, hstepB = g.hstepB;
    const unsigned ldsw = (unsigned)wid * 1024u;
    const int aoff = lds_byte(wr * 64 + fr, fq * 8), boff = lds_byte(wc * 32 + fr, fq * 8);
#define PG8_SA(b, h) (((b) * 2 + (h)) * HTB)
#define PG8_SB(b, h) ((4 + (b) * 2 + (h)) * HTB)
#define PG8_STAGE(bufoff, gbase, voff) do { _Pragma("unroll") for (int _i = 0; _i < 2; ++_i) \
        __builtin_amdgcn_global_load_lds((const unsigned*)((const char*)(gbase) + (voff)[_i]), (LAS unsigned*)(lds + (bufoff) + ldsw + _i * 8192), 16, 0, 0); } while (0)
#define PG8_LDA(dst, b, h) do { _Pragma("unroll") for (int m = 0; m < 4; ++m) _Pragma("unroll") for (int k = 0; k < 2; ++k) dst[m][k] = *(const LAS bf16x8*)(lds + PG8_SA(b, h) + aoff + m * 2048 + k * 1024); } while (0)
#define PG8_LDB(dst, b, h) do { _Pragma("unroll") for (int n = 0; n < 2; ++n) _Pragma("unroll") for (int k = 0; k < 2; ++k) dst[n][k] = *(const LAS bf16x8*)(lds + PG8_SB(b, h) + boff + n * 2048 + k * 1024); } while (0)
#define PG8_MMA(ai, bj, At, Bt) do { __builtin_amdgcn_s_setprio(1); _Pragma("unroll") for (int m = 0; m < 4; ++m) _Pragma("unroll") for (int n = 0; n < 2; ++n) _Pragma("unroll") for (int k = 0; k < 2; ++k) \
        acc[ai][bj][m][n] = __builtin_amdgcn_mfma_f32_16x16x32_bf16(Bt[n][k], At[m][k], acc[ai][bj][m][n], 0, 0, 0); __builtin_amdgcn_s_setprio(0); } while (0)
#define PG8_WAIT_V(n) asm volatile("s_waitcnt vmcnt(" #n ")" ::: "memory")
#define PG8_WAIT_L(n) asm volatile("s_waitcnt lgkmcnt(" #n ")" ::: "memory")
#define PG8_BAR __builtin_amdgcn_s_barrier()
#define PG8_SCHED __builtin_amdgcn_sched_barrier(0)
    Unit cur, nxt; int ui = 0;
    if (!S.next(0, cur)) return;
    f32x4 acc[2][2][4][2];
#pragma unroll
    for (int a = 0; a < 2; ++a)
#pragma unroll
        for (int b = 0; b < 2; ++b)
#pragma unroll
            for (int m = 0; m < 4; ++m)
#pragma unroll
                for (int n = 0; n < 2; ++n) acc[a][b][m][n] = (f32x4){0.f, 0.f, 0.f, 0.f};
    bf16x8 At[4][2], B0[2][2], B1[2][2];
    const char* cA = g.A + (long)cur.pm * g.tstepA; const char* cB = g.Bt + (long)cur.pn * g.tstepB + (long)cur.pm * g.zstepB;
    PG8_STAGE(PG8_SB(0, 0), cB, voffB); PG8_STAGE(PG8_SB(0, 1), cB + hstepB, voffB); PG8_STAGE(PG8_SA(0, 0), cA, voffA); PG8_STAGE(PG8_SA(0, 1), cA + hstepA, voffA);
    if (wr == 1) PG8_BAR;
    PG8_WAIT_V(2); PG8_BAR;
    PG8_STAGE(PG8_SB(1, 0), cB + kstepB, voffB); PG8_STAGE(PG8_SA(1, 0), cA + kstepA, voffA); PG8_STAGE(PG8_SB(1, 1), cB + hstepB + kstepB, voffB);
    PG8_WAIT_V(6); PG8_BAR;
    for (;;) {
        const bool has_next = S.next(ui + 1, nxt);
        const char* nA = has_next ? g.A + (long)nxt.pm * g.tstepA : cA; const char* nB = has_next ? g.Bt + (long)nxt.pn * g.tstepB + (long)nxt.pm * g.zstepB : cB;
        for (int t = 0; t < nt; t += 2) {
            const bool last = (t == nt - 2);
            const char* a1 = cA + (long)(t + 1) * kstepA;
            const char* a2 = last ? nA : cA + (long)(t + 2) * kstepA; const char* b2 = last ? nB : cB + (long)(t + 2) * kstepB;
            const char* a3 = a2 + kstepA; const char* b3 = b2 + kstepB;
            PG8_LDB(B0, 0, 0); PG8_LDB(B1, 0, 1); PG8_SCHED; PG8_LDA(At, 0, 0); PG8_STAGE(PG8_SA(1, 1), a1 + hstepA, voffA);
            PG8_WAIT_V(8); PG8_WAIT_L(0); PG8_BAR; PG8_MMA(0, 0, At, B0); PG8_MMA(0, 1, At, B1); PG8_BAR; PG8_SCHED;
            PG8_LDA(At, 0, 1); PG8_STAGE(PG8_SB(0, 0), b2, voffB); PG8_STAGE(PG8_SB(0, 1), b2 + hstepB, voffB); PG8_STAGE(PG8_SA(0, 0), a2, voffA);
            PG8_WAIT_V(8); PG8_WAIT_L(0); PG8_BAR; PG8_MMA(1, 0, At, B0); PG8_MMA(1, 1, At, B1); PG8_BAR; PG8_SCHED;
            PG8_LDB(B0, 1, 0); PG8_LDB(B1, 1, 1); PG8_SCHED; PG8_LDA(At, 1, 0); PG8_STAGE(PG8_SA(0, 1), a2 + hstepA, voffA);
            PG8_WAIT_V(8); PG8_WAIT_L(0); PG8_BAR; PG8_MMA(0, 0, At, B0); PG8_MMA(0, 1, At, B1); PG8_BAR; PG8_SCHED;
            PG8_LDA(At, 1, 1); PG8_STAGE(PG8_SB(1, 0), b3, voffB); PG8_STAGE(PG8_SB(1, 1), b3 + hstepB, voffB); PG8_STAGE(PG8_SA(1, 0), a3, voffA);
            PG8_WAIT_V(8); PG8_WAIT_L(0); PG8_BAR; PG8_MMA(1, 0, At, B0); PG8_MMA(1, 1, At, B1); PG8_BAR; PG8_SCHED;
        }
        if (wr == 0) PG8_BAR;
        { int fr_ = fr, fq_ = fq; asm volatile("" : "+v"(fr_), "+v"(fq_)); E(acc, cur, wr, wc, fr_, fq_); }
        if (!has_next) break;
#pragma unroll
        for (int a = 0; a < 2; ++a)
#pragma unroll
            for (int b = 0; b < 2; ++b)
#pragma unroll
                for (int m = 0; m < 4; ++m)
#pragma unroll
                    for (int n = 0; n < 2; ++n) acc[a][b][m][n] = (f32x4){0.f, 0.f, 0.f, 0.f};
        cur = nxt; cA = nA; cB = nB; ++ui;
        if (wr == 1) PG8_BAR;
    }
    PG8_WAIT_V(0);
    PG8_BAR;
#undef PG8_SA
#undef PG8_SB
#undef PG8_STAGE
#undef PG8_LDA
#undef PG8_LDB
#undef PG8_MMA
#undef PG8_WAIT_V
#undef PG8_WAIT_L
#undef PG8_BAR
#undef PG8_SCHED
}
}
typedef f32x4 AccT[2][2][4][2];
#define EPI_ROWS(ai, m) (u.pm * 256 + (ai) * 128 + wr * 64 + (m) * 16 + fr)
#define EPI_COL0(bj) (u.pn * 256 + (bj) * 128 + wc * 32 + 8 * fq)
#define EPI_FOR_AM _Pragma("unroll") for (int ai = 0; ai < 2; ++ai) _Pragma("unroll") for (int m = 0; m < 4; ++m)
#define EPI_FOR_BJ _Pragma("unroll") for (int bj = 0; bj < 2; ++bj)

__device__ __forceinline__ void ssq_add(float* ssq, int row, float s, int fq) { s += __shfl_xor(s, 16); s += __shfl_xor(s, 32); if (fq == 0) atomicAdd(ssq + row, s); }
__device__ __forceinline__ float sq8(const f32x4 a, const f32x4 b) { return (a[0] * a[0] + a[1] * a[1]) + (a[2] * a[2] + a[3] * a[3]) + (b[0] * b[0] + b[1] * b[1]) + (b[2] * b[2] + b[3] * b[3]); }

struct EpiInProj {
    static constexpr bool PERM = true;
    unsigned char* ws; int l;
    template <int KIND> __device__ __forceinline__ void body(const AccT& acc, const pg8::Unit& u, int wr, int wc, int fr, int fq, int cbase) const {
        const float* ssq_mix = (const float*)(ws + CTL_SSQ) + (size_t)ssq_idx(l, 0) * T; float* ssq_q = (float*)(ws + CTL_SSQ) + (size_t)ssq_idx(l, 1) * T; float* ssq_kv = (float*)(ws + CTL_SSQ) + (size_t)ssq_idx(l, 2) * T;
        bf16_t* Up = (bf16_t*)(ws + WS_UP); bf16_t* qlat = (bf16_t*)(ws + WS_QLAT); bf16_t* kvlat = (bf16_t*)(ws + WS_KVLAT); bf16_t* hgq = (bf16_t*)(ws + WS_HGQ); bf16_t* hgi = (bf16_t*)(ws + WS_HGI); bf16_t* kpe = (bf16_t*)(ws + WS_KPE);
        _Float16* hgxf = (_Float16*)(ws + WS_HGXF); const float* cosT = (const float*)(ws + WS_COS); const float* sinT = (const float*)(ws + WS_SIN);
        EPI_FOR_AM { const int row = EPI_ROWS(ai, m); const float rs = rstd_of(ssq_mix[row], 1.f / DM); float sacc = 0.f;
            EPI_FOR_BJ { const int col = EPI_COL0(bj) - cbase; f32x4 v0 = acc[ai][bj][m][0] * rs, v1 = acc[ai][bj][m][1] * rs;
                if (KIND == 0) { const int g = col >> 4, hp = col & 15, ch = row >> 6, s = row & 63; *(u32x4*)(Up + ((size_t)(g * 256 + ch) * 1024 + s * 16 + hp)) = pack8(v0, v1); }
                if (KIND == 1) { sacc += sq8(v0, v1); *(u32x4*)(qlat + (size_t)row * 512 + col) = pack8(v0, v1); }
                if (KIND == 2) { sacc += sq8(v0, v1); *(u32x4*)(kvlat + (size_t)row * 256 + col) = pack8(v0, v1); }
                if (KIND == 3) { _Pragma("unroll") for (int i = 0; i < 4; ++i) { v0[i] = siluf_(v0[i]); v1[i] = siluf_(v1[i]); } *(u32x4*)(hgq + (size_t)row * 512 + col) = pack8(v0, v1); }
                if (KIND == 4) { typedef _Float16 h8 __attribute__((ext_vector_type(8))); h8 h; _Pragma("unroll") for (int i = 0; i < 4; ++i) { h[i] = (_Float16)v0[i]; h[4 + i] = (_Float16)v1[i]; } *(h8*)(hgxf + (size_t)row * 512 + col) = h; }
                if (KIND == 5) { *(u32x4*)(hgi + (size_t)row * 512 + col) = pack8(v0, v1); }
                if (KIND == 6) { if (bj == 0 && wc == 0) {
                        const int j0 = 8 * (fq & 1); const f32x4 c0 = *(const f32x4*)(cosT + (size_t)row * 16 + j0), c1 = *(const f32x4*)(cosT + (size_t)row * 16 + j0 + 4);
                        const f32x4 s0 = *(const f32x4*)(sinT + (size_t)row * 16 + j0), s1 = *(const f32x4*)(sinT + (size_t)row * 16 + j0 + 4); const float sg = (fq < 2) ? -1.f : 1.f;
                        f32x4 o0, o1; _Pragma("unroll") for (int i = 0; i < 4; ++i) { const float p0 = __shfl_xor(v0[i], 32), p1 = __shfl_xor(v1[i], 32); o0[i] = v0[i] * c0[i] + sg * p0 * s0[i]; o1[i] = v1[i] * c1[i] + sg * p1 * s1[i]; }
                        *(u32x4*)(kpe + (size_t)row * 32 + 8 * fq) = pack8(o0, o1); } }
            }
            if (KIND == 1) ssq_add(ssq_q, row, sacc, fq);
            if (KIND == 2) ssq_add(ssq_kv, row, sacc, fq);
        }
    }
    __device__ __forceinline__ void operator()(const AccT& acc, const pg8::Unit& u, int wr, int wc, int fr, int fq) const {
        const int pn = u.pn;
        if (pn < 2) body<0>(acc, u, wr, wc, fr, fq, 0);
        else if (pn < 4) body<1>(acc, u, wr, wc, fr, fq, 512);
        else if (pn < 5) body<2>(acc, u, wr, wc, fr, fq, 1024);
        else if (pn < 7) body<3>(acc, u, wr, wc, fr, fq, 1280);
        else if (pn < 9) body<4>(acc, u, wr, wc, fr, fq, 1792);
        else if (pn < 11) body<5>(acc, u, wr, wc, fr, fq, 2304);
        else body<6>(acc, u, wr, wc, fr, fq, 2816);
    }
};
struct EpiQ {
    static constexpr bool PERM = true;
    const float* ssq; bf16_t* Q; const float* cosT; const float* sinT; float scale;
    __device__ __forceinline__ void operator()(const AccT& acc, const pg8::Unit& u, int wr, int wc, int fr, int fq) const {
        EPI_FOR_AM { const int row = EPI_ROWS(ai, m); const float rs = rstd_of(ssq[row], 1.f / 512) * scale;
            EPI_FOR_BJ { const int col = EPI_COL0(bj); f32x4 v0 = acc[ai][bj][m][0] * rs, v1 = acc[ai][bj][m][1] * rs; const int gi = u.pn * 8 + bj * 4 + wc;
                if (gi % 3 == 2) { const int j0 = 8 * (fq & 1); const f32x4 c0 = *(const f32x4*)(cosT + (size_t)row * 16 + j0), c1 = *(const f32x4*)(cosT + (size_t)row * 16 + j0 + 4);
                    const f32x4 s0 = *(const f32x4*)(sinT + (size_t)row * 16 + j0), s1 = *(const f32x4*)(sinT + (size_t)row * 16 + j0 + 4); const float sg = (fq < 2) ? -1.f : 1.f;
                    f32x4 o0, o1; _Pragma("unroll") for (int i = 0; i < 4; ++i) { const float p0 = __shfl_xor(v0[i], 32), p1 = __shfl_xor(v1[i], 32); o0[i] = v0[i] * c0[i] + sg * p0 * s0[i]; o1[i] = v1[i] * c1[i] + sg * p1 * s1[i]; }
                    v0 = o0; v1 = o1; }
                *(u32x4*)(Q + (size_t)row * 768 + col) = pack8(v0, v1); } }
    }
};
template <int ACT> struct EpiRowBf16 {
    static constexpr bool PERM = true;
    const float* ssq; float inv_n; float scale; bf16_t* O; int ldc;
    __device__ __forceinline__ void operator()(const AccT& acc, const pg8::Unit& u, int wr, int wc, int fr, int fq) const {
        EPI_FOR_AM { const int row = EPI_ROWS(ai, m); const float rs = (ssq ? rstd_of(ssq[row], inv_n) : 1.f) * scale;
            EPI_FOR_BJ { const int col = EPI_COL0(bj); f32x4 v0 = acc[ai][bj][m][0] * rs, v1 = acc[ai][bj][m][1] * rs;
                if (ACT == 1) { _Pragma("unroll") for (int i = 0; i < 4; ++i) { v0[i] = siluf_(v0[i]); v1[i] = siluf_(v1[i]); } }
                if (ACT == 2) { _Pragma("unroll") for (int i = 0; i < 4; ++i) { v0[i] = sigmoidf_(v0[i]); v1[i] = sigmoidf_(v1[i]); } }
                *(u32x4*)(O + (size_t)row * ldc + col) = pack8(v0, v1); } }
    }
};
struct EpiColBf16 {
    static constexpr bool PERM = true;
    const float* ssq; float inv_n; bf16_t* O; int ldc;
    __device__ __forceinline__ void operator()(const AccT& acc, const pg8::Unit& u, int wr, int wc, int fr, int fq) const {
        EPI_FOR_BJ { const int col = EPI_COL0(bj); f32x4 r0 = *(const f32x4*)(ssq + col), r1 = *(const f32x4*)(ssq + col + 4);
            _Pragma("unroll") for (int i = 0; i < 4; ++i) { r0[i] = rstd_of(r0[i], inv_n); r1[i] = rstd_of(r1[i], inv_n); }
            EPI_FOR_AM { const int row = EPI_ROWS(ai, m); *(u32x4*)(O + (size_t)row * ldc + col) = pack8(acc[ai][bj][m][0] * r0, acc[ai][bj][m][1] * r1); } }
    }
};
template <int MODE> struct EpiMerge {
    static constexpr bool PERM = true;
    const bf16_t* GT; const bf16_t* ZT; bf16_t* MG;
    __device__ __forceinline__ void operator()(const AccT& acc, const pg8::Unit& u, int wr, int wc, int fr, int fq) const {
        EPI_FOR_AM { const int row = EPI_ROWS(ai, m);
            EPI_FOR_BJ { const size_t off = (size_t)row * 1024 + EPI_COL0(bj); f32x4 g0, g1; unpack8(*(const u32x4*)(GT + off), g0, g1); f32x4 v0 = acc[ai][bj][m][0], v1 = acc[ai][bj][m][1];
                if (MODE == 0) { f32x4 z0, z1; unpack8(*(const u32x4*)(ZT + off), z0, z1); _Pragma("unroll") for (int i = 0; i < 4; ++i) { v0[i] = g0[i] * z0[i] * sigmoidf_(v0[i]); v1[i] = g1[i] * z1[i] * sigmoidf_(v1[i]); } }
                else { f32x4 p0, p1; unpack8(*(const u32x4*)(MG + off), p0, p1); v0 = p0 + g0 * v0; v1 = p1 + g1 * v1; }
                *(u32x4*)(MG + off) = pack8(v0, v1); } }
    }
};
struct EpiResid {
    static constexpr bool PERM = true;
    const float* Xin; float* X; bf16_t* XB; float* ssq;
    __device__ __forceinline__ void operator()(const AccT& acc, const pg8::Unit& u, int wr, int wc, int fr, int fq) const {
        EPI_FOR_AM { const int row = EPI_ROWS(ai, m); float sacc = 0.f;
            EPI_FOR_BJ { const size_t off = (size_t)row * 1024 + EPI_COL0(bj); const f32x4 v0 = *(const f32x4*)(Xin + off) + acc[ai][bj][m][0], v1 = *(const f32x4*)(Xin + off + 4) + acc[ai][bj][m][1];
                *(f32x4*)(X + off) = v0; *(f32x4*)(X + off + 4) = v1; *(u32x4*)(XB + off) = pack8(v0, v1); sacc += sq8(v0, v1); }
            ssq_add(ssq, row, sacc, fq); }
    }
};
struct EpiSwiGLU {
    static constexpr bool PERM = true;
    const float* ssq; bf16_t* H;
    __device__ __forceinline__ void operator()(const AccT& acc, const pg8::Unit& u, int wr, int wc, int fr, int fq) const {
        EPI_FOR_AM { const int row = EPI_ROWS(ai, m); const float rs = rstd_of(ssq[row], 1.f / DM);
            f32x4 g0 = acc[ai][0][m][0] * rs, g1 = acc[ai][0][m][1] * rs; const f32x4 u0 = acc[ai][1][m][0] * rs, u1 = acc[ai][1][m][1] * rs;
            _Pragma("unroll") for (int i = 0; i < 4; ++i) { g0[i] = siluf_(g0[i]) * u0[i]; g1[i] = siluf_(g1[i]) * u1[i]; }
            *(u32x4*)(H + (size_t)row * DFF + u.pn * 128 + wc * 32 + 8 * fq) = pack8(g0, g1); }
    }
};

#define XB_TMO      128
#define XB_XCNT(j)  (256  + 64 * (j))
#define XB_XSUB(j)  (1280 + 64 * (j))
#define XB_XGEN(j)  (2304 + 64 * (j))
#define XB_TOP      3328
#define XB_TOPGEN   3392
#define XCD_BAR_WORDS 3456
#define XB_SPIN_CAP (1u << 18)
__device__ __forceinline__ unsigned xb_ld(unsigned* p)              { return __hip_atomic_load(p, __ATOMIC_RELAXED, __HIP_MEMORY_SCOPE_AGENT); }
__device__ __forceinline__ unsigned xb_add(unsigned* p, unsigned v) { return __hip_atomic_fetch_add(p, v, __ATOMIC_RELAXED, __HIP_MEMORY_SCOPE_AGENT); }
__device__ __forceinline__ unsigned xb_xcc_id() { return (unsigned)__builtin_amdgcn_s_getreg((3 << 11) | 20) & 0xFu; }
#define XB_SPIN(cond, bar) do { unsigned _sp = 0; while (cond) { __builtin_amdgcn_s_sleep(1); \
    if ((++_sp & 255u) == 0u) { if (xb_ld(&(bar)[XB_TMO])) break; if (_sp > XB_SPIN_CAP) { atomicAdd(&(bar)[XB_TMO], 1u); break; } } } } while (0)
struct XcdBarrier { unsigned* bar; unsigned x; volatile LAS unsigned* st; };
__device__ __forceinline__ XcdBarrier xcd_barrier_post(unsigned* bar, volatile LAS unsigned* st) {
    XcdBarrier b; b.bar = bar; b.x = xb_xcc_id(); b.st = st;
    if (threadIdx.x == 0) (void)xb_add(&bar[XB_XCNT(b.x)], 1u);
    return b;
}
__device__ __forceinline__ void xcd_barrier_complete(unsigned* bar, unsigned x, unsigned& nloc, unsigned& nx) {
    const unsigned G = gridDim.x * gridDim.y * gridDim.z;
    unsigned sum, cnt, mine, sp = 0u;
    for (;;) {
        sum = 0u; cnt = 0u; mine = 0u;
#pragma unroll
        for (unsigned j = 0; j < 16; ++j) { const unsigned c = xb_ld(&bar[XB_XCNT(j)]); sum += c; cnt += (c > 0u) ? 1u : 0u; mine = (j == x) ? c : mine; }
        if (sum == G) break;
        __builtin_amdgcn_s_sleep(1);
        if ((++sp & 255u) == 0u) { if (xb_ld(&bar[XB_TMO])) break; if (sp > XB_SPIN_CAP) { atomicAdd(&bar[XB_TMO], 1u); break; } }
    }
    nloc = mine > 0u ? mine : 1u; nx = cnt > 0u ? cnt : 1u;
}
__device__ __forceinline__ void xcd_barrier(const XcdBarrier& b) {
    asm volatile("s_waitcnt vmcnt(0)" ::: "memory");
    __syncthreads();
    if (threadIdx.x == 0) {
        unsigned* bar = b.bar;
        __builtin_amdgcn_s_waitcnt(0);
        unsigned nloc = b.st[0], nx = b.st[1];
        if (nloc == 0u) { xcd_barrier_complete(bar, b.x, nloc, nx); b.st[0] = nloc; b.st[1] = nx; }
        const unsigned old = xb_add(&bar[XB_XSUB(b.x)], 1u);
        const unsigned gen = old / nloc;
        if (old + 1u == (gen + 1u) * nloc) {
            __builtin_amdgcn_fence(__ATOMIC_RELEASE, "agent");
            asm volatile("s_waitcnt vmcnt(0)" ::: "memory");
            const unsigned og = xb_add(&bar[XB_TOP], 1u);
            const unsigned tg = og / nx;
            if (og + 1u == (tg + 1u) * nx) xb_add(&bar[XB_TOPGEN], 1u);
            else XB_SPIN(xb_ld(&bar[XB_TOPGEN]) == tg, bar);
            __builtin_amdgcn_fence(__ATOMIC_ACQUIRE, "agent");
            xb_add(&bar[XB_XGEN(b.x)], 1u);
            asm volatile("s_waitcnt vmcnt(0)" ::: "memory");
        } else {
            XB_SPIN(xb_ld(&bar[XB_XGEN(b.x)]) == gen, bar);
            __builtin_amdgcn_fence(__ATOMIC_ACQUIRE, "agent");
            asm volatile("s_waitcnt vmcnt(0)" ::: "memory");
        }
    }
    __syncthreads();
}

enum { I_X = 0, I_MEM, I_POS, I_NORM_MIX, I_W_IN, I_LAM_RE, I_LAM_IM, I_B_RE, I_B_IM, I_C_RE, I_C_IM, I_SSM_D, I_LOG_STEP, I_W_GLU, I_Q_NORM, I_KV_NORM, I_W_UQ, I_W_UKV, I_MLA_WO,
       I_HG_LB, I_HG_GNORM, I_HG_WO, I_W_OUT, I_NORM_CROSS, I_NORM_MEM, I_XWQ, I_XWKV, I_XWO, I_NORM_FFN, I_W_GU, I_W_DOWN, I_NORM_FINAL };

constexpr int RING_BYTES = 131072, MISC_OFF = RING_BYTES + 320, LDS_BYTES = 147456;
struct Args { const float* in[32]; float* out; unsigned char* ws; int ph_lo, ph_hi; };
struct Frame {
    LAS unsigned char* lds; int tid, lane, wave, G, gw, NGW;
    const float* const* in; float* out; unsigned char* ws;
};
#define WSP(T_, off) ((T_*)(F.ws + (off)))
__device__ __forceinline__ float* ssq_ptr(const Frame& F, int l, int k) { return (float*)(F.ws + CTL_SSQ) + (size_t)ssq_idx(l, k) * T; }

__constant__ float ROPE_INVF[16] = {1.0f, 0.5623413324356079f, 0.3162277638912201f, 0.17782793939113617f, 0.10000000149011612f, 0.05623413249850273f, 0.03162277489900589f, 0.017782794311642647f,
    0.009999999776482582f, 0.005623413249850273f, 0.003162277629598975f, 0.0017782794311642647f, 0.0010000000474974513f, 0.000562341301701963f, 0.0003162277571391314f, 0.00017782794020604342f};
struct ConvTab { int in_idx, gain_idx, K, Nsrc, map, aux, layer; unsigned dst_kib; };
__constant__ ConvTab CONV_TAB[13] = {
    {I_W_IN, I_NORM_MIX, 1024, 6432, 1, 0, -1, (unsigned)(WS_WBIG >> 10)},
    {I_W_GLU, -1, 512, 2048, 0, 0, -1, (unsigned)(WS_WGLU >> 10)},
    {I_W_UQ, I_Q_NORM, 512, 768, 0, 0, -1, (unsigned)(WS_WUQ >> 10)},
    {I_W_UKV, I_KV_NORM, 256, 1024, 2, 0, -1, 0u},
    {I_MLA_WO, -1, 512, 1024, 0, 0, -1, (unsigned)(WS_WMO >> 10)},
    {I_HG_WO, -1, 512, 1024, 0, 0, -1, (unsigned)(WS_WHO >> 10)},
    {I_W_OUT, -1, 1024, 1024, 0, 0, -1, (unsigned)(WS_WOUT >> 10)},
    {I_XWQ, I_NORM_CROSS, 1024, 512, 0, 0, -1, (unsigned)(WS_WXQ >> 10)},
    {I_XWO, -1, 512, 1024, 0, 0, -1, (unsigned)(WS_WXO >> 10)},
    {I_W_GU, I_NORM_FFN, 1024, 5632, 3, 2816, -1, (unsigned)(WS_WGU >> 10)},
    {I_W_DOWN, -1, 2816, 1024, 0, 0, -1, (unsigned)(WS_WD >> 10)},
    {I_XWKV, I_NORM_MEM, 1024, 1024, 4, 0, 0, (unsigned)(WS_WXK >> 10)},
    {I_XWKV, I_NORM_MEM, 1024, 1024, 4, 0, 1, (unsigned)((WS_WXK + MiB) >> 10)},
};
__device__ __forceinline__ bf16_t* conv_dst(const Frame& F, int map, int n, int K, size_t dst_off, int aux) {
    if (map == 1) { int r; if (n < 1280) r = n; else if (n < 1312) r = 2816 + (n - 1280); else if (n < 2848) r = n - 32; else if (n < 3360) r = 3072 + (n - 2848); else r = 3584 + (n - 3360); return WSP(bf16_t, WS_WBIG) + (size_t)r * 1024; }
    if (map == 2) { const int h = n >> 7, j = n & 127; return (j < 64) ? WSP(bf16_t, WS_WUK) + (size_t)(h * 64 + j) * 256 : WSP(bf16_t, WS_WUV) + (size_t)(h * 64 + j - 64) * 256; }
    if (map == 3) { const int half = (n >= aux) ? 1 : 0, f = n - half * aux; return WSP(bf16_t, dst_off) + (size_t)((f >> 7) * 256 + half * 128 + (f & 127)) * 1024; }
    if (map == 4) { return (n < 512) ? WSP(bf16_t, dst_off) + (size_t)n * 1024 : WSP(bf16_t, dst_off + 2 * MiB) + (size_t)(n - 512) * 1024; }
    return WSP(bf16_t, dst_off) + (size_t)n * K;
}
__device__ __forceinline__ void convert_weights(const Frame& F, int l, int j0, int j1) {
    LAS float* scr = (LAS float*)(F.lds + F.wave * 16384);
    int total = 0;
    for (int j = j0; j < j1; ++j) total += (CONV_TAB[j].K / 64) * (CONV_TAB[j].Nsrc / 32);
    const int lane = F.lane;
    for (int it = F.gw; it < total; it += F.NGW) {
        int j = j0, r = it;
        for (;;) { const int c = (CONV_TAB[j].K / 64) * (CONV_TAB[j].Nsrc / 32); if (r < c) break; r -= c; ++j; }
        const int K = CONV_TAB[j].K, Nsrc = CONV_TAB[j].Nsrc, map = CONV_TAB[j].map, aux = CONV_TAB[j].aux, ll = CONV_TAB[j].layer < 0 ? l : CONV_TAB[j].layer;
        const size_t dst_off = (size_t)CONV_TAB[j].dst_kib << 10;
        const float* W = F.in[CONV_TAB[j].in_idx] + (size_t)ll * K * Nsrc; const int gi = CONV_TAB[j].gain_idx; const float* gain = F.in[gi < 0 ? 0 : gi] + (size_t)ll * K;
        const int nblk = Nsrc / 32, kb = r / nblk, nb = r % nblk, k0 = 64 * kb, n0 = 32 * nb;
#pragma unroll 4
        for (int i = 0; i < 32; ++i) { const int kk = 2 * i + (lane >> 5); float w = W[(size_t)(k0 + kk) * Nsrc + n0 + (lane & 31)]; if (gi >= 0) w *= gain[k0 + kk]; scr[kk * 33 + (lane & 31)] = w; }
        LDS_WAIT(); asm volatile("" ::: "memory");
        const int c = lane & 7;
#pragma unroll
        for (int q = 0; q < 4; ++q) { const int n = (lane >> 3) + 8 * q; const LAS float* sp = scr + (8 * c) * 33 + n;
            u32x4 o; o.x = pk2(sp[0 * 33], sp[1 * 33]); o.y = pk2(sp[2 * 33], sp[3 * 33]); o.z = pk2(sp[4 * 33], sp[5 * 33]); o.w = pk2(sp[6 * 33], sp[7 * 33]);
            *(u32x4*)(conv_dst(F, map, n0 + n, K, dst_off, aux) + k0 + 8 * c) = o; }
        LDS_WAIT(); asm volatile("" ::: "memory");
    }
}
__device__ __forceinline__ void convert_mixer_weights(const Frame& F, int l) { convert_weights(F, l, 0, 9); }
__device__ __forceinline__ void convert_ffn_weights(const Frame& F, int l) { convert_weights(F, l, 9, 11); }
__device__ __forceinline__ void prologue0(const Frame& F) {
    const float* x = F.in[I_X]; bf16_t* XB = WSP(bf16_t, WS_XB); float* ssq0 = ssq_ptr(F, 0, 0);
    for (int r = F.gw; r < T; r += F.NGW) {
        const f32x4* xr = (const f32x4*)(x + (size_t)r * DM) + F.lane; f32x4 v[4]; float s = 0.f;
#pragma unroll
        for (int j = 0; j < 4; ++j) { v[j] = xr[64 * j]; s += (v[j][0] * v[j][0] + v[j][1] * v[j][1]) + (v[j][2] * v[j][2] + v[j][3] * v[j][3]); }
        s = wave_sum(s); if (F.lane == 0) ssq0[r] = s;
        u32x2* o = (u32x2*)(XB + (size_t)r * DM) + F.lane;
#pragma unroll
        for (int j = 0; j < 4; ++j) { u32x2 w; w.x = pk2(v[j][0], v[j][1]); w.y = pk2(v[j][2], v[j][3]); o[64 * j] = w; }
    }
    const int* pos = (const int*)F.in[I_POS]; float* cosT = WSP(float, WS_COS); float* sinT = WSP(float, WS_SIN);
    for (int i = F.gw * 64 + F.lane; i < T * 16; i += F.NGW * 64) { const int r = i >> 4, j = i & 15;
        const float invf = ROPE_INVF[j];
        const float ang = (float)pos[r] * invf; float s, c; sincos_rad((double)ang, s, c); cosT[i] = c; sinT[i] = s; }
    const float* mem = F.in[I_MEM]; bf16_t* memn = WSP(bf16_t, WS_MEMN);
    for (int r = F.gw; r < NB * NMEM; r += F.NGW) {
        const f32x4* xr = (const f32x4*)(mem + (size_t)r * DM) + F.lane; f32x4 v[4]; float s = 0.f;
#pragma unroll
        for (int j = 0; j < 4; ++j) { v[j] = xr[64 * j]; s += (v[j][0] * v[j][0] + v[j][1] * v[j][1]) + (v[j][2] * v[j][2] + v[j][3] * v[j][3]); }
        const float rs = rstd_of(wave_sum(s), 1.f / DM);
        u32x2* o = (u32x2*)(memn + (size_t)r * DM) + F.lane;
#pragma unroll
        for (int j = 0; j < 4; ++j) { u32x2 w; w.x = pk2(v[j][0] * rs, v[j][1] * rs); w.y = pk2(v[j][2] * rs, v[j][3] * rs); o[64 * j] = w; }
    }
    convert_weights(F, 0, 11, 13);
}

__device__ __forceinline__ void s5_pow(float lr, float li, float step, int n, float& re, float& im) {
    const float mag = __expf(lr * step * (float)n); float sn, cs; sincos_rad((double)li * (double)step * (double)n, sn, cs); re = mag * cs; im = mag * sn;
}
__device__ __forceinline__ void s5_coef(float lr, float li, float step, float& cr, float& ci) {
    float br, bi; s5_pow(lr, li, step, 1, br, bi); const float den = 1.f / (lr * lr + li * li), nr = br - 1.f, ni = bi; cr = (nr * lr + ni * li) * den; ci = (ni * lr - nr * li) * den;
}
__device__ __forceinline__ void s5_tables(const Frame& F, int l) {
    const float* LR = F.in[I_LAM_RE] + l * 2048; const float* LI = F.in[I_LAM_IM] + l * 2048; const float* LS = F.in[I_LOG_STEP] + l * 32;
    const float* BR = F.in[I_B_RE] + (size_t)l * 32768; const float* BI = F.in[I_B_IM] + (size_t)l * 32768; const float* CR = F.in[I_C_RE] + (size_t)l * 32768; const float* CI = F.in[I_C_IM] + (size_t)l * 32768;
    const float* DS = F.in[I_SSM_D] + l * 512;
    bf16_t* TZ = WSP(bf16_t, WS_TOEP); bf16_t* BM_ = WSP(bf16_t, WS_BMAT); bf16_t* CM = WSP(bf16_t, WS_CMAT);
    const int tid = F.tid;
    LAS float* zr = (LAS float*)(F.lds + 12288);     LAS float* zi = zr + 64; LAS float* red = zi + 64;
    for (int it = blockIdx.x; it < 32 * 64; it += F.G) {
        const int g = it >> 6, tau = it & 63;
        if (tid < 64) { const float lr = LR[g * 64 + tid], li = LI[g * 64 + tid], step = __expf(LS[g]); float wr_, wi_, cr, ci; s5_pow(lr, li, step, tau, wr_, wi_); s5_coef(lr, li, step, cr, ci);
            zr[tid] = wr_ * cr - wi_ * ci; zi[tid] = wr_ * ci + wi_ * cr; }
        __syncthreads();
        const int o = tid & 255, h = o >> 4, hp = o & 15, half = tid >> 8; float acc = 0.f;
#pragma unroll 4
        for (int q = 0; q < 32; ++q) { const int p = half * 32 + q; const float cre = CR[(g * 16 + h) * 64 + p], cim = CI[(g * 16 + h) * 64 + p], bre = BR[(g * 64 + p) * 16 + hp], bim = BI[(g * 64 + p) * 16 + hp];
            acc += zr[p] * (cre * bre - cim * bim) - zi[p] * (cre * bim + cim * bre); }
        if (half == 1) red[o] = acc;
        __syncthreads();
        if (half == 0) { acc += red[o]; if (tau == 0 && h == hp) acc += DS[g * 16 + h]; TZ[(size_t)g * 127 * 256 + (tau + 63) * 256 + o] = (bf16_t)(pk2(acc, 0.f) & 0xffffu); }
        else if (tau > 0) TZ[(size_t)g * 127 * 256 + (63 - tau) * 256 + o] = 0;
    }
    for (int idx = blockIdx.x * NTHREADS + tid; idx < 32 * 64 * 64; idx += F.G * NTHREADS) {
        const int g = idx >> 12, p = (idx >> 6) & 63, sI = idx & 63; const float lr = LR[g * 64 + p], li = LI[g * 64 + p], step = __expf(LS[g]);
        float wr_, wi_, cr, ci; s5_pow(lr, li, step, 63 - sI, wr_, wi_); s5_coef(lr, li, step, cr, ci); const float zr_ = wr_ * cr - wi_ * ci, zi_ = wr_ * ci + wi_ * cr;
        f32x4 re[4], im[4];
#pragma unroll
        for (int q = 0; q < 4; ++q) { const f32x4 br = *(const f32x4*)(BR + (g * 64 + p) * 16 + 4 * q), bi = *(const f32x4*)(BI + (g * 64 + p) * 16 + 4 * q); re[q] = zr_ * br - zi_ * bi; im[q] = zr_ * bi + zi_ * br; }
        bf16_t* d0 = BM_ + ((size_t)(g * 128 + 2 * p) * 1024 + sI * 16);
        *(u32x4*)d0 = pack8(re[0], re[1]); *(u32x4*)(d0 + 8) = pack8(re[2], re[3]); *(u32x4*)(d0 + 1024) = pack8(im[0], im[1]); *(u32x4*)(d0 + 1032) = pack8(im[2], im[3]);
    }
    for (int idx = blockIdx.x * NTHREADS + tid; idx < 32 * 64 * 64; idx += F.G * NTHREADS) {
        const int g = idx >> 12, t = (idx >> 6) & 63, p = idx & 63; const float lr = LR[g * 64 + p], li = LI[g * 64 + p], step = __expf(LS[g]);
        float wr_, wi_; s5_pow(lr, li, step, t + 1, wr_, wi_);
#pragma unroll 4
        for (int h = 0; h < 16; ++h) { const float cre = CR[(g * 16 + h) * 64 + p], cim = CI[(g * 16 + h) * 64 + p];
            *(unsigned*)(CM + ((size_t)(g * 1024 + t * 16 + h) * 128 + 2 * p)) = pk2(cre * wr_ - cim * wi_, -(cre * wi_ + cim * wr_)); }
    }
    if (blockIdx.x == 0 && tid < 128) *(unsigned*)(CM + (size_t)32 * 1024 * 128 + 2 * tid) = 0u;
}
__device__ __forceinline__ void s5_scan(const Frame& F, int l) {
    const int idx = blockIdx.x * NTHREADS + F.tid; if (idx >= NB * 32 * 64) return;
    const int b = idx >> 11, g = (idx >> 6) & 31, p = idx & 63;
    const float lr = F.in[I_LAM_RE][l * 2048 + g * 64 + p], li = F.in[I_LAM_IM][l * 2048 + g * 64 + p], step = __expf(F.in[I_LOG_STEP][l * 32 + g]);
    float ar, ai; s5_pow(lr, li, step, 64, ar, ai);
    const f32x2* SU = WSP(f32x2, WS_SUMS) + ((size_t)(g * 256 + b * 64) * 64 + p); bf16_t* XS = WSP(bf16_t, WS_XST) + (size_t)(g * 256 + b * 64) * 256;
    float xr = 0.f, xi = 0.f;
    for (int c0 = 0; c0 < 64; c0 += 16) { f32x2 sv[16];
#pragma unroll
        for (int c = 0; c < 16; ++c) sv[c] = SU[(size_t)(c0 + c) * 64];
#pragma unroll
        for (int c = 0; c < 16; ++c) { bf16_t* xo = XS + (size_t)(c0 + c) * 256; *(unsigned*)(xo + 2 * p) = pk2(xr, xi); *(unsigned*)(xo + 128 + 2 * p) = 0u;
            const float nr = ar * xr - ai * xi + sv[c][0], ni = ar * xi + ai * xr + sv[c][1]; xr = nr; xi = ni; } }
}
struct EpiS5Intra { static constexpr bool PERM = true; bf16_t* YS;
    __device__ __forceinline__ void operator()(const AccT& acc, const pg8::Unit& u, int wr, int wc, int fr, int fq) const {
        EPI_FOR_AM { const int row = EPI_ROWS(ai, m), g = u.pm, ch = row & 255;
            EPI_FOR_BJ { const int n = EPI_COL0(bj), t = n >> 4, h0 = n & 15; *(u32x4*)(YS + (size_t)(ch * 64 + t) * 512 + g * 16 + h0) = pack8(acc[ai][bj][m][0], acc[ai][bj][m][1]); } }
    } };
struct EpiS5State { static constexpr bool PERM = true; float* SU;
    __device__ __forceinline__ void operator()(const AccT& acc, const pg8::Unit& u, int wr, int wc, int fr, int fq) const {
        EPI_FOR_AM { const int row = EPI_ROWS(ai, m); float* d = SU + (size_t)row * 128 + wc * 32 + 8 * fq; *(f32x4*)d = acc[ai][0][m][0]; *(f32x4*)(d + 4) = acc[ai][0][m][1]; }
    } };
struct EpiS5Inter { static constexpr bool PERM = true; bf16_t* YS;
    __device__ __forceinline__ void operator()(const AccT& acc, const pg8::Unit& u, int wr, int wc, int fr, int fq) const {
        EPI_FOR_AM { const int row = EPI_ROWS(ai, m), g = u.pm, ch = row & 255;
            EPI_FOR_BJ { const int n = EPI_COL0(bj), t = n >> 4, h0 = n & 15; bf16_t* yp = YS + (size_t)(ch * 64 + t) * 512 + g * 16 + h0; f32x4 y0, y1; unpack8(*(const u32x4*)yp, y0, y1);
                y0 += acc[ai][bj][m][0]; y1 += acc[ai][bj][m][1]; _Pragma("unroll") for (int i = 0; i < 4; ++i) { y0[i] = geluf_(y0[i]); y1[i] = geluf_(y1[i]); }
                *(u32x4*)yp = pack8(y0, y1); } }
    } };
__device__ __forceinline__ void naive_s5(const Frame& F, int l) {
    if (F.wave != 0 || blockIdx.x >= NB * 32) return;
    const int b = blockIdx.x >> 5, g = blockIdx.x & 31, p = F.lane;
    LAS float* cre = (LAS float*)F.lds; LAS float* cim = cre + 1024; LAS float* xs = cim + 1024;
    const float* c_re = F.in[I_C_RE] + ((size_t)l * 32 + g) * 1024; const float* c_im = F.in[I_C_IM] + ((size_t)l * 32 + g) * 1024;
    for (int i = p; i < 1024; i += 64) { cre[i] = c_re[i]; cim[i] = c_im[i]; }
    const float step = __expf(F.in[I_LOG_STEP][l * 32 + g]);
    const float lr = F.in[I_LAM_RE][(l * 32 + g) * 64 + p], li = F.in[I_LAM_IM][(l * 32 + g) * 64 + p];
    float sn, cs; sincos_rad((double)li * (double)step, sn, cs); const float mag = __expf(lr * step); const float lbr = mag * cs, lbi = mag * sn;
    const float den = 1.f / (lr * lr + li * li); const float nr = lbr - 1.f, ni = lbi; const float cfr = (nr * lr + ni * li) * den, cfi = (ni * lr - nr * li) * den;
    float bbr[16], bbi[16];
    const float* b_re = F.in[I_B_RE] + (((size_t)l * 32 + g) * 64 + p) * 16; const float* b_im = F.in[I_B_IM] + (((size_t)l * 32 + g) * 64 + p) * 16;
#pragma unroll
    for (int h = 0; h < 16; ++h) { const float br = b_re[h], bi = b_im[h]; bbr[h] = cfr * br - cfi * bi; bbi[h] = cfr * bi + cfi * br; }
    const float dsk = (p < 16) ? F.in[I_SSM_D][(l * 32 + g) * 16 + p] : 0.f;
    const bf16_t* Up = WSP(bf16_t, WS_UP) + (size_t)g * 256 * 1024; bf16_t* YS = WSP(bf16_t, WS_YS);
    float xr = 0.f, xi = 0.f; LDS_WAIT();
    for (int t = 0; t < SEQ; ++t) {
        const int ch = b * 64 + (t >> 6), s = t & 63;
        const u32x4* up = (const u32x4*)(Up + (size_t)ch * 1024 + s * 16); f32x4 u0, u1, u2, u3; unpack8(up[0], u0, u1); unpack8(up[1], u2, u3);
        float ur = 0.f, ui = 0.f;
#pragma unroll
        for (int h = 0; h < 4; ++h) { ur += bbr[h] * u0[h] + bbr[4 + h] * u1[h] + bbr[8 + h] * u2[h] + bbr[12 + h] * u3[h]; ui += bbi[h] * u0[h] + bbi[4 + h] * u1[h] + bbi[8 + h] * u2[h] + bbi[12 + h] * u3[h]; }
        const float nxr = lbr * xr - lbi * xi + ur, nxi = lbr * xi + lbi * xr + ui; xr = nxr; xi = nxi;
        xs[p] = xr; xs[64 + p] = xi; LDS_WAIT(); __builtin_amdgcn_wave_barrier();
        if (p < 16) { float y = 0.f;
#pragma unroll 8
            for (int q = 0; q < 64; ++q) y += cre[p * 64 + q] * xs[q] - cim[p * 64 + q] * xs[64 + q];
            const float uu = (p < 4) ? u0[p & 3] : (p < 8) ? u1[p & 3] : (p < 12) ? u2[p & 3] : u3[p & 3];
            y = geluf_(y + dsk * uu);
            YS[(size_t)(b * SEQ + t) * 512 + g * 16 + p] = (bf16_t)(pk2(y, 0.f) & 0xffffu); }
        LDS_WAIT(); __builtin_amdgcn_wave_barrier();
    }
}

namespace hg {
constexpr int QA = 0, KB = QA + 64 * 272, KD = KB + 64 * 272, VT = KD + 128 * 144, AT = VT + 128 * 144, ST = AT + 64 * 144, TOT = ST + 128 * 272, BL = TOT + 2048, RS = BL + 1024, END = RS + 1024;
static_assert(END <= RING_BYTES, "hgrn LDS map");
}
__device__ __forceinline__ float hg_lower_bound(const Frame& F, int l, int h, int d) {
    if (l == 0) return 0.f;
    const float a0 = F.in[I_HG_LB][h * 128 + d], a1 = F.in[I_HG_LB][512 + h * 128 + d]; const float mx = fmaxf(a0, a1); const float e0 = __expf(a0 - mx), e1 = __expf(a1 - mx); return e1 / (e0 + e1);
}
template <bool OUT> __device__ __forceinline__ float hg_prep(const Frame& F, size_t row0, int h, float lb) {
    const int tid = F.tid, d = tid & 127, qtr = tid >> 7, t0 = 16 * qtr;
    LAS float* tot = (LAS float*)(F.lds + hg::TOT); LAS float* blm = (LAS float*)(F.lds + hg::BL);
    const _Float16* XF = WSP(_Float16, WS_HGXF) + row0 * 512 + h * 128 + d; const bf16_t* HQ = WSP(bf16_t, WS_HGQ) + row0 * 512 + h * 128 + d; const bf16_t* HI = WSP(bf16_t, WS_HGI) + row0 * 512 + h * 128 + d;
    float lf[16], kk[16]; float run = 0.f;
#pragma unroll
    for (int i = 0; i < 16; ++i) { const float x = (float)XF[(size_t)(t0 + i) * 512]; const float sg = sigmoidf_(x); kk[i] = (1.f - lb) * (1.f - sg); run += __logf(lb + (1.f - lb) * sg); lf[i] = run; }
    tot[qtr * 128 + d] = run;
    __syncthreads();
    const float t0_ = tot[d], t1_ = tot[128 + d], t2_ = tot[256 + d], t3_ = tot[384 + d];
    const float bmid = t0_ + t1_, blast = bmid + t2_ + t3_; const float prefix = (qtr > 0 ? t0_ : 0.f) + (qtr > 1 ? t1_ : 0.f) + (qtr > 2 ? t2_ : 0.f);
    if (qtr == 0) { blm[d] = blast; blm[128 + d] = bmid; }
    float kd[16], vv[16];
#pragma unroll
    for (int i = 0; i < 16; ++i) { const float b = prefix + lf[i]; kd[i] = kk[i] * fexp2((blast - b) * LOG2E); vv[i] = bf2f(HI[(size_t)(t0 + i) * 512]);
        if (OUT) { const float q = bf2f(HQ[(size_t)(t0 + i) * 512]); const float qa = q * fexp2((b - bmid) * LOG2E), kb = kk[i] * fexp2((bmid - b) * LOG2E);
            *(LAS bf16_t*)(F.lds + hg::QA + (t0 + i) * 272 + d * 2) = (bf16_t)(pk2(qa, 0.f) & 0xffffu); *(LAS bf16_t*)(F.lds + hg::KB + (t0 + i) * 272 + d * 2) = (bf16_t)(pk2(kb, 0.f) & 0xffffu); } }
    { LAS u32x4* kp = (LAS u32x4*)(F.lds + hg::KD + d * 144 + t0 * 2); LAS u32x4* vp = (LAS u32x4*)(F.lds + hg::VT + d * 144 + t0 * 2);
      kp[0] = pack8((f32x4){kd[0], kd[1], kd[2], kd[3]}, (f32x4){kd[4], kd[5], kd[6], kd[7]}); kp[1] = pack8((f32x4){kd[8], kd[9], kd[10], kd[11]}, (f32x4){kd[12], kd[13], kd[14], kd[15]});
      vp[0] = pack8((f32x4){vv[0], vv[1], vv[2], vv[3]}, (f32x4){vv[4], vv[5], vv[6], vv[7]}); vp[1] = pack8((f32x4){vv[8], vv[9], vv[10], vv[11]}, (f32x4){vv[12], vv[13], vv[14], vv[15]}); }
    return blast;
}
__device__ __forceinline__ void hg_state_update(const Frame& F, f32x16 (&sacc)[2], int eb, int db0, int r32, int hi) {
    const LAS float* blm = (const LAS float*)(F.lds + hg::BL);
#pragma unroll
    for (int tI = 0; tI < 2; ++tI) { const int db = db0 + tI; const float dec = fexp2(blm[32 * db + r32] * LOG2E); sacc[tI] = sacc[tI] * dec;
#pragma unroll
        for (int ks = 0; ks < 4; ++ks) { const bf16x8 a = *(const LAS bf16x8*)(F.lds + hg::VT + (32 * eb + r32) * 144 + (16 * ks + 8 * hi) * 2), bq = *(const LAS bf16x8*)(F.lds + hg::KD + (32 * db + r32) * 144 + (16 * ks + 8 * hi) * 2);
            sacc[tI] = __builtin_amdgcn_mfma_f32_32x32x16_bf16(a, bq, sacc[tI], 0, 0, 0); } }
}
__device__ __forceinline__ void hgrn_U(const Frame& F, int l) {
    const int unit = blockIdx.x; if (unit >= 256) return;
    const int bh = unit >> 4, sc = unit & 15, b = bh >> 2, h = bh & 3, tid = F.tid, lane = F.lane, r32 = lane & 31, hi = lane >> 5, w = F.wave, eb = w >> 1, db0 = 2 * (w & 1);
    const float lb = hg_lower_bound(F, l, h, tid & 127);
    f32x16 sacc[2]; sacc[0] = (f32x16){0.f}; sacc[1] = (f32x16){0.f}; float dsum = 0.f;
    for (int c = 0; c < 4; ++c) { const size_t row0 = (size_t)b * SEQ + sc * 256 + c * 64;
        dsum += hg_prep<false>(F, row0, h, lb);
        __syncthreads();
        hg_state_update(F, sacc, eb, db0, r32, hi);
    }
    bf16_t* US = WSP(bf16_t, WS_HGUS) + (size_t)unit * 16384;
#pragma unroll
    for (int tI = 0; tI < 2; ++tI)
#pragma unroll
        for (int r = 0; r < 16; ++r) US[(32 * eb + crow16(r, hi)) * 128 + 32 * (db0 + tI) + r32] = (bf16_t)(pk2(sacc[tI][r], 0.f) & 0xffffu);
    if (tid < 128) WSP(float, WS_HGDEC)[unit * 128 + tid] = fexp2(dsum * LOG2E);
}
__device__ __forceinline__ void hgrn_scan(const Frame& F) {
    const int idx = blockIdx.x * NTHREADS + F.tid; if (idx >= 16 * 8192) return;
    const int bh = idx >> 13, e2 = idx & 8191; unsigned* US = WSP(unsigned, WS_HGUS) + (size_t)bh * 16 * 8192 + e2; const float* DC = WSP(float, WS_HGDEC) + bh * 16 * 128 + ((2 * e2) & 127);
    unsigned u[16]; f32x2 dd[16];
#pragma unroll
    for (int sc = 0; sc < 16; ++sc) { u[sc] = US[(size_t)sc * 8192]; dd[sc] = *(const f32x2*)(DC + sc * 128); }
    float s0 = 0.f, s1 = 0.f;
#pragma unroll
    for (int sc = 0; sc < 16; ++sc) { US[(size_t)sc * 8192] = pk2(s0, s1); s0 = dd[sc][0] * s0 + __uint_as_float(u[sc] << 16); s1 = dd[sc][1] * s1 + __uint_as_float(u[sc] & 0xffff0000u); }
}
__device__ __forceinline__ void hgrn_O(const Frame& F, int l) {
    const int unit = blockIdx.x; if (unit >= 256) return;
    const int bh = unit >> 4, sc = unit & 15, b = bh >> 2, h = bh & 3, tid = F.tid, lane = F.lane, r32 = lane & 31, hi = lane >> 5, w = F.wave, eb = w >> 1, tb = w & 1, db0 = 2 * (w & 1);
    const float lb = hg_lower_bound(F, l, h, tid & 127);
    const bf16_t* US = WSP(bf16_t, WS_HGUS) + (size_t)unit * 16384; const float* GN = F.in[I_HG_GNORM] + l * 128;
    f32x16 sacc[2];
#pragma unroll
    for (int tI = 0; tI < 2; ++tI)
#pragma unroll
        for (int r = 0; r < 16; ++r) sacc[tI][r] = bf2f(US[(32 * eb + crow16(r, hi)) * 128 + 32 * (db0 + tI) + r32]);
    const LAS float* blm = (const LAS float*)(F.lds + hg::BL); LAS float* rsx = (LAS float*)(F.lds + hg::RS);
    for (int c = 0; c < 4; ++c) { const size_t row0 = (size_t)b * SEQ + sc * 256 + c * 64;
        (void)hg_prep<true>(F, row0, h, lb);
#pragma unroll
        for (int tI = 0; tI < 2; ++tI) { const int dcol = 32 * (db0 + tI) + r32; const LAS float* tot = (const LAS float*)(F.lds + hg::TOT); const float sc_ = fexp2((tot[dcol] + tot[128 + dcol]) * LOG2E);
#pragma unroll
            for (int r = 0; r < 16; ++r) *(LAS bf16_t*)(F.lds + hg::ST + (32 * eb + crow16(r, hi)) * 272 + dcol * 2) = (bf16_t)(pk2(sacc[tI][r] * sc_, 0.f) & 0xffffu); }
        __syncthreads();
        f32x16 o = (f32x16){0.f};
#pragma unroll
        for (int ks = 0; ks < 8; ++ks) { const bf16x8 a = *(const LAS bf16x8*)(F.lds + hg::ST + (32 * eb + r32) * 272 + (16 * ks + 8 * hi) * 2), bq = *(const LAS bf16x8*)(F.lds + hg::QA + (32 * tb + r32) * 272 + (16 * ks + 8 * hi) * 2);
            o = __builtin_amdgcn_mfma_f32_32x32x16_bf16(a, bq, o, 0, 0, 0); }
        if (w < 4 && !(w == 2)) {
            const int sb = w >> 1, tb2 = w & 1; f32x16 at = (f32x16){0.f};
#pragma unroll
            for (int ks = 0; ks < 8; ++ks) { const bf16x8 a = *(const LAS bf16x8*)(F.lds + hg::KB + (32 * sb + r32) * 272 + (16 * ks + 8 * hi) * 2), bq = *(const LAS bf16x8*)(F.lds + hg::QA + (32 * tb2 + r32) * 272 + (16 * ks + 8 * hi) * 2);
                at = __builtin_amdgcn_mfma_f32_32x32x16_bf16(a, bq, at, 0, 0, 0); }
            const int t = 32 * tb2 + r32;
#pragma unroll
            for (int rr = 0; rr < 4; ++rr) { const int s0 = 32 * sb + 8 * rr + 4 * hi; u32x2 wv; float a0 = at[4 * rr], a1 = at[4 * rr + 1], a2 = at[4 * rr + 2], a3 = at[4 * rr + 3];
                if (s0 > t) a0 = 0.f; if (s0 + 1 > t) a1 = 0.f; if (s0 + 2 > t) a2 = 0.f; if (s0 + 3 > t) a3 = 0.f; wv.x = pk2(a0, a1); wv.y = pk2(a2, a3);
                *(LAS u32x2*)(F.lds + hg::AT + t * 144 + s0 * 2) = wv; }
        }
        __syncthreads();
        { const int nks = tb == 0 ? 2 : 4;
          for (int ks = 0; ks < nks; ++ks) { const bf16x8 a = *(const LAS bf16x8*)(F.lds + hg::VT + (32 * eb + r32) * 144 + (16 * ks + 8 * hi) * 2), bq = *(const LAS bf16x8*)(F.lds + hg::AT + (32 * tb + r32) * 144 + (16 * ks + 8 * hi) * 2);
              o = __builtin_amdgcn_mfma_f32_32x32x16_bf16(a, bq, o, 0, 0, 0); } }
        float ss = 0.f;
#pragma unroll
        for (int r = 0; r < 16; ++r) ss += o[r] * o[r];
        ss += __shfl_xor(ss, 32);
        if (hi == 0) rsx[eb * 64 + 32 * tb + r32] = ss;
        __syncthreads();
        { const int t = 32 * tb + r32; const float rs = rstd_of((rsx[t] + rsx[64 + t]) + (rsx[128 + t] + rsx[192 + t]), 1.f / 128);
          bf16_t* outp = WSP(bf16_t, WS_HGQ) + (row0 + t) * 512 + h * 128; const bf16_t* sgp = WSP(bf16_t, WS_HGSG) + (row0 + t) * 512 + h * 128;
#pragma unroll
          for (int rr = 0; rr < 4; ++rr) { const int e0 = 32 * eb + 8 * rr + 4 * hi; const u32x2 sgw = *(const u32x2*)(sgp + e0); const f32x4 gn = *(const f32x4*)(GN + e0);
              const float y0 = o[4 * rr] * rs * gn[0] * __uint_as_float(sgw.x << 16), y1 = o[4 * rr + 1] * rs * gn[1] * __uint_as_float(sgw.x & 0xffff0000u);
              const float y2 = o[4 * rr + 2] * rs * gn[2] * __uint_as_float(sgw.y << 16), y3 = o[4 * rr + 3] * rs * gn[3] * __uint_as_float(sgw.y & 0xffff0000u);
              u32x2 wv; wv.x = pk2(y0, y1); wv.y = pk2(y2, y3); *(u32x2*)(outp + e0) = wv; } }
        if (c < 3) hg_state_update(F, sacc, eb, db0, r32, hi);
    }
}
__device__ __forceinline__ void naive_hgrn(const Frame& F, int l) {
    if (blockIdx.x >= NB * 4) return;
    const int b = blockIdx.x >> 2, h = blockIdx.x & 3, tid = F.tid, e = tid & 127, dq = tid >> 7;
    LAS float* qf = (LAS float*)F.lds; LAS float* ff = qf + 128; LAS float* kk = ff + 128; LAS float* part = kk + 128; LAS float* ob = part + 512;
    float lb = 0.f;
    if (l == 1) { const float a0 = F.in[I_HG_LB][h * 128 + e], a1 = F.in[I_HG_LB][512 + h * 128 + e]; const float mx = fmaxf(a0, a1); const float e0 = __expf(a0 - mx), e1 = __expf(a1 - mx); lb = e1 / (e0 + e1); }
    const float gn = F.in[I_HG_GNORM][l * 128 + e];
    bf16_t* HGQ = WSP(bf16_t, WS_HGQ); const _Float16* HGXF = WSP(_Float16, WS_HGXF); const bf16_t* HGI = WSP(bf16_t, WS_HGI); const bf16_t* HGSG = WSP(bf16_t, WS_HGSG);
    float Sreg[32];
#pragma unroll
    for (int d = 0; d < 32; ++d) Sreg[d] = 0.f;
    for (int t = 0; t < SEQ; ++t) {
        const size_t ro = (size_t)(b * SEQ + t) * 512 + h * 128;
        if (dq == 0) { const float xf = (float)HGXF[ro + e]; const float sg = sigmoidf_(xf); qf[e] = bf2f(HGQ[ro + e]); ff[e] = lb + (1.f - lb) * sg; kk[e] = (1.f - lb) * (1.f - sg); }
        const float v = bf2f(HGI[ro + e]);
        __syncthreads();
        float po = 0.f;
#pragma unroll
        for (int d = 0; d < 32; ++d) { const int dd = dq * 32 + d; Sreg[d] = ff[dd] * Sreg[d] + kk[dd] * v; po += qf[dd] * Sreg[d]; }
        part[dq * 128 + e] = po;
        __syncthreads();
        float o = 0.f;
        if (dq == 0) { o = (part[e] + part[128 + e]) + (part[256 + e] + part[384 + e]); ob[e] = o; }
        __syncthreads();
        if (dq == 0) { float ss = 0.f;
#pragma unroll 8
            for (int j = 0; j < 128; ++j) ss += ob[j] * ob[j];
            const float y = o * rstd_of(ss, 1.f / 128) * gn * bf2f(HGSG[ro + e]);
            HGQ[ro + e] = (bf16_t)(pk2(y, 0.f) & 0xffffu); }
    }
}

__device__ __forceinline__ void naive_attn(const Frame& F) {
    const int gt = blockIdx.x * NTHREADS + F.tid; const int h = gt >> 14, tok = gt & (T - 1), b = tok >> 12, tl = tok & (SEQ - 1);
    bf16_t* Q = WSP(bf16_t, WS_Q); const bf16_t* KN = WSP(bf16_t, WS_QLAT); const bf16_t* KPE = WSP(bf16_t, WS_KPE); const bf16_t* VT = WSP(bf16_t, WS_UP);
    u32x4 qp[12];
#pragma unroll
    for (int i = 0; i < 12; ++i) qp[i] = *(const u32x4*)(Q + (size_t)tok * 768 + h * 96 + i * 8);
    float acc[64];
#pragma unroll
    for (int d = 0; d < 64; ++d) acc[d] = 0.f;
    float mrun = -1e30f, lrun = 0.f;
    const int tmax = __builtin_amdgcn_readfirstlane(((blockIdx.x * NTHREADS + (F.tid | 63)) & (SEQ - 1)));
    for (int s0 = 0; s0 <= tmax; s0 += 8) {
        float sc[8];
#pragma unroll
        for (int j = 0; j < 8; ++j) { const size_t kr = (size_t)(b * SEQ + s0 + j); float s = 0.f;
#pragma unroll
            for (int i = 0; i < 8; ++i) { f32x4 k0, k1, q0, q1; unpack8(*(const u32x4*)(KN + kr * 512 + h * 64 + i * 8), k0, k1); unpack8(qp[i], q0, q1);
                s += (q0[0] * k0[0] + q0[1] * k0[1]) + (q0[2] * k0[2] + q0[3] * k0[3]) + (q1[0] * k1[0] + q1[1] * k1[1]) + (q1[2] * k1[2] + q1[3] * k1[3]); }
#pragma unroll
            for (int i = 0; i < 4; ++i) { f32x4 k0, k1, q0, q1; unpack8(*(const u32x4*)(KPE + kr * 32 + i * 8), k0, k1); unpack8(qp[8 + i], q0, q1);
                s += (q0[0] * k0[0] + q0[1] * k0[1]) + (q0[2] * k0[2] + q0[3] * k0[3]) + (q1[0] * k1[0] + q1[1] * k1[1]) + (q1[2] * k1[2] + q1[3] * k1[3]); }
            sc[j] = (s0 + j <= tl) ? s : -1e30f; }
        float mx = mrun;
#pragma unroll
        for (int j = 0; j < 8; ++j) mx = fmaxf(mx, sc[j]);
        const float f = fexp2(mrun - mx); mrun = mx; lrun *= f;
#pragma unroll
        for (int j = 0; j < 8; ++j) { sc[j] = (s0 + j <= tl) ? fexp2(sc[j] - mx) : 0.f; lrun += sc[j]; }
#pragma unroll
        for (int d = 0; d < 64; ++d) { f32x4 v0, v1; unpack8(*(const u32x4*)(VT + (size_t)(h * 64 + d) * T + b * SEQ + s0), v0, v1);
            acc[d] = acc[d] * f + (sc[0] * v0[0] + sc[1] * v0[1]) + (sc[2] * v0[2] + sc[3] * v0[3]) + (sc[4] * v1[0] + sc[5] * v1[1]) + (sc[6] * v1[2] + sc[7] * v1[3]); }
    }
    const float il = 1.f / lrun;
#pragma unroll
    for (int d = 0; d < 64; d += 8) { f32x4 a, c2; _Pragma("unroll") for (int i = 0; i < 4; ++i) { a[i] = acc[d + i] * il; c2[i] = acc[d + 4 + i] * il; }
        *(u32x4*)(Q + (size_t)tok * 768 + h * 96 + d) = pack8(a, c2); }
}
__device__ __forceinline__ void naive_xattn(const Frame& F, int l) {
  for (int pass = 0; pass < 2; ++pass) {
    const int gt = (pass * F.G + blockIdx.x) * NTHREADS + F.tid; const int hv = gt >> 14, tok = gt & (T - 1), b = tok >> 12, h = hv >> 2, vq = hv & 3;
    const bf16_t* QX = WSP(bf16_t, WS_QX); bf16_t* OX = WSP(bf16_t, WS_OX); const bf16_t* MK = WSP(bf16_t, WS_MEMK + (size_t)l * MiB); const bf16_t* MVT = WSP(bf16_t, WS_MEMVT + (size_t)l * MiB);
    float acc[32];
#pragma unroll
    for (int d = 0; d < 32; ++d) acc[d] = 0.f;
    float mrun = -1e30f, lrun = 0.f;
    for (int s0 = 0; s0 < NMEM; s0 += 8) {
        float sc[8];
#pragma unroll
        for (int j = 0; j < 8; ++j) { const size_t kr = (size_t)(b * NMEM + s0 + j); float s = 0.f;
#pragma unroll 4
            for (int i = 0; i < 16; ++i) { f32x4 k0, k1, q0, q1; unpack8(*(const u32x4*)(MK + kr * 512 + h * 128 + i * 8), k0, k1); unpack8(*(const u32x4*)(QX + (size_t)tok * 512 + h * 128 + i * 8), q0, q1);
                s += (q0[0] * k0[0] + q0[1] * k0[1]) + (q0[2] * k0[2] + q0[3] * k0[3]) + (q1[0] * k1[0] + q1[1] * k1[1]) + (q1[2] * k1[2] + q1[3] * k1[3]); }
            sc[j] = s; }
        float mx = mrun;
#pragma unroll
        for (int j = 0; j < 8; ++j) mx = fmaxf(mx, sc[j]);
        const float f = fexp2(mrun - mx); mrun = mx; lrun *= f;
#pragma unroll
        for (int j = 0; j < 8; ++j) { sc[j] = fexp2(sc[j] - mx); lrun += sc[j]; }
#pragma unroll
        for (int d = 0; d < 32; ++d) { f32x4 v0, v1; unpack8(*(const u32x4*)(MVT + (size_t)(h * 128 + vq * 32 + d) * (NB * NMEM) + b * NMEM + s0), v0, v1);
            acc[d] = acc[d] * f + (sc[0] * v0[0] + sc[1] * v0[1]) + (sc[2] * v0[2] + sc[3] * v0[3]) + (sc[4] * v1[0] + sc[5] * v1[1]) + (sc[6] * v1[2] + sc[7] * v1[3]); }
    }
    const float il = 1.f / lrun;
#pragma unroll
    for (int d = 0; d < 32; d += 8) { f32x4 a, c2; _Pragma("unroll") for (int i = 0; i < 4; ++i) { a[i] = acc[d + i] * il; c2[i] = acc[d + 4 + i] * il; }
        *(u32x4*)(OX + (size_t)tok * 512 + h * 128 + vq * 32 + d) = pack8(a, c2); }
  }
}
template <int DQK, int DV, bool CAUSAL, bool KPE>
__device__ __forceinline__ void attn_unit(const Frame& F, const bf16_t* Qp, int ldq, const bf16_t* Kp, int ldk, const bf16_t* Kpe, const bf16_t* Vt, int ldv, bf16_t* Op, int ldo, int q0, int ntiles) {
    constexpr int KSTR = DQK * 2 + 16, VSTR = 136, KBYTES = 64 * KSTR, VBYTES = DV * VSTR, BUF = KBYTES + VBYTES;
    constexpr int KPR = DQK / 8, KPIECES = 64 * KPR, KIT = (KPIECES + NTHREADS - 1) / NTHREADS, VPIECES = DV * 8, VIT = VPIECES / NTHREADS, NKS = DQK / 16, NVB = DV / 32;
    constexpr int KA = KPE ? (DQK - 32) / 8 : KPR;
    const int tid = F.tid, lane = F.lane, r32 = lane & 31, hi = lane >> 5, wave = F.wave;
    const int qrow = q0 + wave * 32 + r32;
    bf16x8 qf[NKS];
#pragma unroll
    for (int ks = 0; ks < NKS; ++ks) qf[ks] = *(const bf16x8*)(Qp + (size_t)qrow * ldq + ks * 16 + hi * 8);
    f32x16 o[NVB];
#pragma unroll
    for (int i = 0; i < NVB; ++i) o[i] = (f32x16){0.f};
    float mrun = -1e30f, lsum = 0.f;
    u32x4 kst[KIT], vst[VIT];
    auto issue = [&](int j) {
#pragma unroll
        for (int i = 0; i < KIT; ++i) { const int p = tid + i * NTHREADS; if (KPIECES % NTHREADS == 0 || p < KPIECES) { const int row = p / KPR, c = p % KPR; const size_t key = (size_t)(j * 64 + row);
            kst[i] = (!KPE || c < KA) ? *(const u32x4*)(Kp + key * ldk + c * 8) : *(const u32x4*)(Kpe + key * 32 + (c - KA) * 8); } }
#pragma unroll
        for (int i = 0; i < VIT; ++i) { const int p = tid + i * NTHREADS; const int row = p >> 3, c = p & 7; vst[i] = *(const u32x4*)(Vt + (size_t)row * ldv + j * 64 + c * 8); }
    };
    auto commit = [&](int buf) {
        LAS unsigned char* kb = F.lds + buf * BUF; LAS unsigned char* vb = kb + KBYTES;
#pragma unroll
        for (int i = 0; i < KIT; ++i) { const int p = tid + i * NTHREADS; if (KPIECES % NTHREADS == 0 || p < KPIECES) { const int row = p / KPR, c = p % KPR; *(LAS u32x4*)(kb + row * KSTR + c * 16) = kst[i]; } }
#pragma unroll
        for (int i = 0; i < VIT; ++i) { const int p = tid + i * NTHREADS; const int row = p >> 3, c = p & 7; LAS unsigned char* d = vb + row * VSTR + c * 16; *(LAS u32x2*)d = (u32x2){vst[i].x, vst[i].y}; *(LAS u32x2*)(d + 8) = (u32x2){vst[i].z, vst[i].w}; }
    };
    issue(0); commit(0); __syncthreads();
    const int qmax_w = q0 + wave * 32 + 31;
    for (int j = 0; j < ntiles; ++j) {
        const int buf = j & 1;
        if (j + 1 < ntiles) issue(j + 1);
        if (!CAUSAL || j * 64 <= qmax_w) {
            const LAS unsigned char* kb = F.lds + buf * BUF + r32 * KSTR + hi * 16; const LAS unsigned char* vb = F.lds + buf * BUF + KBYTES + r32 * VSTR + hi * 8;
            f32x16 p0 = (f32x16){0.f}, p1 = (f32x16){0.f};
#pragma unroll
            for (int ks = 0; ks < NKS; ++ks) { const bf16x8 a0 = *(const LAS bf16x8*)(kb + ks * 32), a1 = *(const LAS bf16x8*)(kb + 32 * KSTR + ks * 32);
                p0 = __builtin_amdgcn_mfma_f32_32x32x16_bf16(a0, qf[ks], p0, 0, 0, 0); p1 = __builtin_amdgcn_mfma_f32_32x32x16_bf16(a1, qf[ks], p1, 0, 0, 0); }
            if (CAUSAL && j * 64 + 63 > q0 + wave * 32) {
#pragma unroll
                for (int r = 0; r < 16; ++r) { const int kv = j * 64 + crow16(r, hi); if (kv > qrow) p0[r] = -1e30f; if (kv + 32 > qrow) p1[r] = -1e30f; } }
            float mx = fmaxf(p0[0], p1[0]);
#pragma unroll
            for (int r = 1; r < 16; ++r) mx = fmaxf(mx, fmaxf(p0[r], p1[r]));
            mx = fmaxf(mx, __shfl_xor(mx, 32));
            const float mnew = fmaxf(mrun, mx);
            if (__any(mnew > mrun)) { const float alpha = fexp2(mrun - mnew); lsum *= alpha;
#pragma unroll
                for (int i = 0; i < NVB; ++i) o[i] = o[i] * alpha;
                mrun = mnew; }
            float ps = 0.f;
#pragma unroll
            for (int r = 0; r < 16; ++r) { p0[r] = fexp2(p0[r] - mrun); p1[r] = fexp2(p1[r] - mrun); ps += p0[r] + p1[r]; }
            lsum += ps;
            bf16x8 pb[4];
            { u32x4 w; w.x = pk2(p0[0], p0[1]); w.y = pk2(p0[2], p0[3]); w.z = pk2(p0[4], p0[5]); w.w = pk2(p0[6], p0[7]); pb[0] = __builtin_bit_cast(bf16x8, w);
              w.x = pk2(p0[8], p0[9]); w.y = pk2(p0[10], p0[11]); w.z = pk2(p0[12], p0[13]); w.w = pk2(p0[14], p0[15]); pb[1] = __builtin_bit_cast(bf16x8, w);
              w.x = pk2(p1[0], p1[1]); w.y = pk2(p1[2], p1[3]); w.z = pk2(p1[4], p1[5]); w.w = pk2(p1[6], p1[7]); pb[2] = __builtin_bit_cast(bf16x8, w);
              w.x = pk2(p1[8], p1[9]); w.y = pk2(p1[10], p1[11]); w.z = pk2(p1[12], p1[13]); w.w = pk2(p1[14], p1[15]); pb[3] = __builtin_bit_cast(bf16x8, w); }
#pragma unroll
            for (int blk = 0; blk < NVB; ++blk)
#pragma unroll
                for (int sI = 0; sI < 4; ++sI) { const LAS unsigned char* va = vb + blk * 32 * VSTR + sI * 32; const u32x2 lo = *(const LAS u32x2*)va, hi2 = *(const LAS u32x2*)(va + 16);
                    const u32x4 w = {lo.x, lo.y, hi2.x, hi2.y}; o[blk] = __builtin_amdgcn_mfma_f32_32x32x16_bf16(__builtin_bit_cast(bf16x8, w), pb[sI], o[blk], 0, 0, 0); }
        }
        if (j + 1 < ntiles) commit(buf ^ 1);
        __syncthreads();
    }
    lsum += __shfl_xor(lsum, 32);
    const float il = frcp(lsum);
#pragma unroll
    for (int blk = 0; blk < NVB; ++blk)
#pragma unroll
        for (int rr = 0; rr < 4; ++rr) { u32x2 w; w.x = pk2(o[blk][4 * rr] * il, o[blk][4 * rr + 1] * il); w.y = pk2(o[blk][4 * rr + 2] * il, o[blk][4 * rr + 3] * il);
            *(u32x2*)(Op + (size_t)qrow * ldo + blk * 32 + 8 * rr + 4 * hi) = w; }
}
__device__ __forceinline__ void mla_attention(const Frame& F) {
    const int bx = blockIdx.x, vcu = (bx & 7) * (F.G >> 3) + (bx >> 3); if (vcu >= 256) return;
    const int bh = vcu >> 3, sI = vcu & 7, b = bh >> 3, h = bh & 7;
    bf16_t* Q = WSP(bf16_t, WS_Q) + (size_t)b * SEQ * 768 + h * 96; const bf16_t* KN = WSP(bf16_t, WS_QLAT) + (size_t)b * SEQ * 512 + h * 64; const bf16_t* KPE = WSP(bf16_t, WS_KPE) + (size_t)b * SEQ * 32;
    const bf16_t* VT = WSP(bf16_t, WS_UP) + (size_t)(h * 64) * T + (size_t)b * SEQ;
    for (int i = 0; i < 2; ++i) { const int qb = i == 0 ? 15 - sI : sI; attn_unit<96, 64, true, true>(F, Q, 768, KN, 512, KPE, VT, T, Q, 768, qb * 256, (qb + 1) * 4); }
}
__device__ __forceinline__ void mem_attention(const Frame& F, int l) {
    const int bx = blockIdx.x, vcu = (bx & 7) * (F.G >> 3) + (bx >> 3); if (vcu >= 256) return;
    const int rb = vcu >> 2, h = vcu & 3, b = rb >> 4;
    const bf16_t* QX = WSP(bf16_t, WS_QX) + (size_t)rb * 256 * 512 + h * 128; bf16_t* OX = WSP(bf16_t, WS_OX) + (size_t)rb * 256 * 512 + h * 128;
    const bf16_t* MK = WSP(bf16_t, WS_MEMK + (size_t)l * MiB) + (size_t)b * NMEM * 512 + h * 128; const bf16_t* MVT = WSP(bf16_t, WS_MEMVT + (size_t)l * MiB) + (size_t)(h * 128) * (NB * NMEM) + b * NMEM;
    attn_unit<128, 128, false, false>(F, QX, 512, MK, 512, nullptr, MVT, NB * NMEM, OX, 512, 0, 4);
}
__device__ __forceinline__ void final_norm(const Frame& F) {
    const float* ssq = ssq_ptr(F, 2, 0); const float* gw_ = F.in[I_NORM_FINAL];
    for (int r = F.gw; r < T; r += F.NGW) { const float rs = rstd_of(ssq[r], 1.f / DM); f32x4* xr = (f32x4*)(F.out + (size_t)r * DM) + F.lane;
#pragma unroll
        for (int j = 0; j < 4; ++j) { const f32x4 g = *((const f32x4*)gw_ + F.lane + 64 * j); xr[64 * j] = xr[64 * j] * rs * g; } }
}

constexpr int NP = 13;
constexpr int NPH = NL * NP + 1;
#define GEMM_RUN(EPI_T, E_, g_) do { pg8::StaticOrder S_; S_.init((g_).nM, (g_).nN, F.G, (int)blockIdx.x); int t_ = F.tid; asm volatile("" : "+v"(t_)); pg8::gemm_phase<EPI_T>(F.lds, t_, (g_), S_, (E_)); } while (0)

template <unsigned PHM> __global__ void __launch_bounds__(NTHREADS, 2) mk_fwd(Args args) {
    extern __shared__ __attribute__((aligned(16))) unsigned char lds_raw[];
    { LAS unsigned* z = (LAS unsigned*)((LAS unsigned char*)lds_raw + RING_BYTES); for (int u = threadIdx.x; u < (LDS_BYTES - RING_BYTES) / 4; u += NTHREADS) z[u] = 0u; }
    __syncthreads();
    unsigned* ctl = (unsigned*)(args.ws + WS_CTL);
    XcdBarrier bar; bar.bar = ctl + CW_BAR; bar.x = 0; bar.st = nullptr;
    const bool one_launch = (args.ph_hi - args.ph_lo) > 1;
    if (one_launch) bar = xcd_barrier_post(ctl + CW_BAR, (volatile LAS unsigned*)((LAS unsigned char*)lds_raw + MISC_OFF) + 8);

    for (int ph = args.ph_lo; ph < args.ph_hi; ++ph) {
        const int l = ph / NP, p = (ph < NL * NP) ? ph % NP : NP;
        int tid_ = threadIdx.x; asm volatile("" : "+v"(tid_));
        int oz = 0; asm volatile("" : "+v"(oz)); oz = __builtin_amdgcn_readfirstlane(oz);
        unsigned char* ws_ = args.ws + oz; const float* const* in_ = args.in + oz; float* out_ = args.out + oz;
        Frame F; F.lds = (LAS unsigned char*)lds_raw; F.tid = tid_; F.lane = F.tid & 63; F.wave = __builtin_amdgcn_readfirstlane(F.tid >> 6); F.G = gridDim.x;
        F.gw = blockIdx.x * NWAVES + F.wave; F.NGW = F.G * NWAVES; F.in = in_; F.out = out_; F.ws = ws_;
        float* const cosT = WSP(float, WS_COS); float* const sinT = WSP(float, WS_SIN);
        const bf16_t* const XB = WSP(bf16_t, WS_XB); const bf16_t* const WBIG = WSP(bf16_t, WS_WBIG);
#define PH_ON(k) (((PHM) >> (k)) & 1u)
        switch (p) {
        case 0: if (PH_ON(0)) {
            if (l == 0) prologue0(F);
            convert_mixer_weights(F, l);
            s5_tables(F, l);
        } break;
        case 1: if (PH_ON(1)) {
            { pg8::Gemm g = pg8::mk(XB, DM, WBIG, DM, T, 3072, DM);
              EpiInProj E{F.ws, l};
              GEMM_RUN(EpiInProj, E, g); }
            if (l == 0) for (int ll = 0; ll < NL; ++ll) {
                { pg8::Gemm g = pg8::mk(WSP(bf16_t, WS_MEMN), DM, WSP(bf16_t, WS_WXK + (size_t)ll * MiB), DM, NB * NMEM, 512, DM);
                  EpiRowBf16<0> E{nullptr, 0.f, 1.f, WSP(bf16_t, WS_MEMK + (size_t)ll * MiB), 512}; GEMM_RUN(EpiRowBf16<0>, E, g); }
                { pg8::Gemm g = pg8::mk(WSP(bf16_t, WS_WXV + (size_t)ll * MiB), DM, WSP(bf16_t, WS_MEMN), DM, 512, NB * NMEM, DM);
                  EpiRowBf16<0> E{nullptr, 0.f, 1.f, WSP(bf16_t, WS_MEMVT + (size_t)ll * MiB), NB * NMEM}; GEMM_RUN(EpiRowBf16<0>, E, g); }
            }
        } break;
        case 2: if (PH_ON(2)) {
            { pg8::Gemm g = pg8::mk(WSP(bf16_t, WS_QLAT), 512, WSP(bf16_t, WS_WUQ), 512, T, 768, 512);
              EpiQ E{ssq_ptr(F, l, 1), WSP(bf16_t, WS_Q), cosT, sinT, 0.10206207261596577f * LOG2E}; GEMM_RUN(EpiQ, E, g); }
#if defined(NAIVE_S5)
            naive_s5(F, l);
#else
            { pg8::Gemm g = pg8::mk(WSP(bf16_t, WS_UP), 1024, WSP(bf16_t, WS_TOEP), 16, 32 * 256, 1024, 1024);
              g.rsB = 32; g.c16B = -512; g.offB = 63 * 256 * 2; g.kstepB = -2048; g.hstepB = 4096; g.tstepB = 8192; g.zstepB = 127 * 256 * 2;
              EpiS5Intra E{WSP(bf16_t, WS_YS)}; GEMM_RUN(EpiS5Intra, E, g); }
            { pg8::Gemm g = pg8::mk(WSP(bf16_t, WS_UP), 1024, WSP(bf16_t, WS_BMAT), 1024, 32 * 256, 256, 1024);
              g.hstepB = 0; g.zstepB = 128 * 1024 * 2; EpiS5State E{WSP(float, WS_SUMS)}; GEMM_RUN(EpiS5State, E, g); }
#endif
        } break;
        case 3: if (PH_ON(3)) {
            { pg8::Gemm g = pg8::mk(WSP(bf16_t, WS_KVLAT), 256, WSP(bf16_t, WS_WUK), 256, T, 512, 256);
              EpiRowBf16<0> E{ssq_ptr(F, l, 2), 1.f / 256, 1.f, WSP(bf16_t, WS_QLAT), 512}; GEMM_RUN(EpiRowBf16<0>, E, g); }
            { pg8::Gemm g = pg8::mk(WSP(bf16_t, WS_WUV), 256, WSP(bf16_t, WS_KVLAT), 256, 512, T, 256);
              EpiColBf16 E{ssq_ptr(F, l, 2), 1.f / 256, WSP(bf16_t, WS_UP), T}; GEMM_RUN(EpiColBf16, E, g); }
            { pg8::Gemm g = pg8::mk(XB, DM, WBIG + (size_t)3072 * DM, DM, T, 512, DM);
              EpiRowBf16<1> E{ssq_ptr(F, l, 0), 1.f / DM, 1.f, WSP(bf16_t, WS_HGSG), 512}; GEMM_RUN(EpiRowBf16<1>, E, g); }
#if !defined(NAIVE_S5)
            s5_scan(F, l);
#endif
#if !defined(NAIVE_HG)
            hgrn_U(F, l);
#endif
        } break;
        case 4: if (PH_ON(4)) {
#if defined(NAIVE_HG)
            mla_attention(F);
            naive_hgrn(F, l);
#else
            hgrn_scan(F);
            mla_attention(F);
#endif
        } break;
        case 5: if (PH_ON(5)) {
#if !defined(NAIVE_S5)
            pg8::Gemm g = pg8::mk(WSP(bf16_t, WS_XST), 256, WSP(bf16_t, WS_CMAT), 128, 32 * 256, 1024, 256); g.zstepB = 1024 * 128 * 2;
            EpiS5Inter E{WSP(bf16_t, WS_YS)}; GEMM_RUN(EpiS5Inter, E, g);
#endif
#if !defined(NAIVE_HG)
            hgrn_O(F, l);
#endif
        } break;
        case 6: if (PH_ON(6)) {
            const bf16_t* WG = WBIG + (size_t)3584 * DM; bf16_t* GT = WSP(bf16_t, WS_GT); bf16_t* ZT = WSP(bf16_t, WS_ZT); bf16_t* MG = WSP(bf16_t, WS_MG);
            { pg8::Gemm g = pg8::mk(XB, DM, WG, DM, T, 1024, DM); EpiRowBf16<2> E{ssq_ptr(F, l, 0), 1.f / DM, 1.f, GT, 1024}; GEMM_RUN(EpiRowBf16<2>, E, g); }
            { pg8::Gemm g = pg8::mk(WSP(bf16_t, WS_YS), 512, WSP(bf16_t, WS_WGLU), 512, T, 1024, 512); EpiRowBf16<0> E{nullptr, 0.f, 1.f, ZT, 1024}; GEMM_RUN(EpiRowBf16<0>, E, g); }
            { pg8::Gemm g = pg8::mk(WSP(bf16_t, WS_YS), 512, WSP(bf16_t, WS_WGLU) + (size_t)1024 * 512, 512, T, 1024, 512); EpiMerge<0> E{GT, ZT, MG}; GEMM_RUN(EpiMerge<0>, E, g); }
            { pg8::Gemm g = pg8::mk(XB, DM, WG + (size_t)1024 * DM, DM, T, 1024, DM); EpiRowBf16<2> E{ssq_ptr(F, l, 0), 1.f / DM, 1.f, GT, 1024}; GEMM_RUN(EpiRowBf16<2>, E, g); }
            { pg8::Gemm g = pg8::mk(WSP(bf16_t, WS_Q), 768, WSP(bf16_t, WS_WMO), 512, T, 1024, 512); g.kstepA = 96 * 2; EpiMerge<1> E{GT, ZT, MG}; GEMM_RUN(EpiMerge<1>, E, g); }
            { pg8::Gemm g = pg8::mk(XB, DM, WG + (size_t)2048 * DM, DM, T, 1024, DM); EpiRowBf16<2> E{ssq_ptr(F, l, 0), 1.f / DM, 1.f, GT, 1024}; GEMM_RUN(EpiRowBf16<2>, E, g); }
            { pg8::Gemm g = pg8::mk(WSP(bf16_t, WS_HGQ), 512, WSP(bf16_t, WS_WHO), 512, T, 1024, 512); EpiMerge<1> E{GT, ZT, MG}; GEMM_RUN(EpiMerge<1>, E, g); }
        } break;
        case 7: if (PH_ON(7)) {
            pg8::Gemm g = pg8::mk(WSP(bf16_t, WS_MG), DM, WSP(bf16_t, WS_WOUT), DM, T, 1024, DM);
            EpiResid E{l == 0 ? F.in[I_X] : F.out, F.out, WSP(bf16_t, WS_XB), ssq_ptr(F, l, 3)}; GEMM_RUN(EpiResid, E, g);
        } break;
        case 8: if (PH_ON(8)) {
            pg8::Gemm g = pg8::mk(XB, DM, WSP(bf16_t, WS_WXQ), DM, T, 512, DM);
            EpiRowBf16<0> E{ssq_ptr(F, l, 3), 1.f / DM, 0.08838834764831845f * LOG2E, WSP(bf16_t, WS_QX), 512}; GEMM_RUN(EpiRowBf16<0>, E, g);
        } break;
        case 9: if (PH_ON(9)) {
            mem_attention(F, l);
            convert_ffn_weights(F, l);
        } break;
        case 10: if (PH_ON(10)) {
            pg8::Gemm g = pg8::mk(WSP(bf16_t, WS_OX), 512, WSP(bf16_t, WS_WXO), 512, T, 1024, 512);
            EpiResid E{F.out, F.out, WSP(bf16_t, WS_XB), ssq_ptr(F, l, 4)}; GEMM_RUN(EpiResid, E, g);
        } break;
        case 11: if (PH_ON(11)) {
            pg8::Gemm g = pg8::mk(XB, DM, WSP(bf16_t, WS_WGU), DM, T, 2 * DFF, DM);
            EpiSwiGLU E{ssq_ptr(F, l, 4), WSP(bf16_t, WS_H)}; GEMM_RUN(EpiSwiGLU, E, g);
        } break;
        case 12: if (PH_ON(12)) {
            pg8::Gemm g = pg8::mk(WSP(bf16_t, WS_H), DFF, WSP(bf16_t, WS_WD), DFF, T, 1024, DFF);
            EpiResid E{F.out, F.out, WSP(bf16_t, WS_XB), ssq_ptr(F, l + 1, 0)}; GEMM_RUN(EpiResid, E, g);
        } break;
        case 13: if (PH_ON(13)) final_norm(F); break;
        default: break;
        }
        if (ph + 1 < args.ph_hi) xcd_barrier(bar);
    }
}

typedef void (*KernFn)(Args);
template <unsigned PHM> static void launch_one(int grid, hipStream_t stream, const Args& a) { hipLaunchKernelGGL(mk_fwd<PHM>, dim3(grid), dim3(NTHREADS), LDS_BYTES, stream, a); }
template <unsigned PHM> static bool prep_one() { return hipFuncSetAttribute((const void*)mk_fwd<PHM>, hipFuncAttributeMaxDynamicSharedMemorySize, LDS_BYTES) == hipSuccess; }
extern "C" void kernel_launch(void* const* d_in, const int* in_sizes, int n_in, void* d_out, int out_size, void* d_ws, size_t ws_size, hipStream_t stream) {
    static int grid = 0;
    if (grid == 0) {
        if (n_in != 32 || out_size != T * DM || ws_size < WS_END) { fprintf(stderr, "kernel_launch: unexpected shapes (n_in %d out %d ws %zu)\n", n_in, out_size, ws_size); grid = -1; return; }
        int dev = 0, cus = 0;
        if (hipGetDevice(&dev) != hipSuccess || hipDeviceGetAttribute(&cus, hipDeviceAttributeMultiprocessorCount, dev) != hipSuccess) { grid = -1; return; }
        bool ok = true;
#if MK_MULTI
        ok = ok && prep_one<1u << 0>() && prep_one<1u << 1>() && prep_one<1u << 2>() && prep_one<1u << 3>() && prep_one<1u << 4>() && prep_one<1u << 6>() && prep_one<1u << 7>() && prep_one<1u << 8>()
                && prep_one<1u << 9>() && prep_one<1u << 10>() && prep_one<1u << 11>() && prep_one<1u << 12>() && prep_one<1u << 13>();
#else
        ok = ok && prep_one<0xFFFFu>();
#endif
        if (!ok) { fprintf(stderr, "kernel_launch: hipFuncSetAttribute failed\n"); grid = -1; return; }
        grid = cus;
        if (grid != 256) fprintf(stderr, "kernel_launch: %d CUs (expected 256)\n", grid);
    }
    if (grid < 0) return;
    (void)hipMemsetAsync((char*)d_ws + WS_CTL, 0, CTL_BYTES, stream);
    Args a{};
    for (int i = 0; i < 32; ++i) a.in[i] = (const float*)d_in[i];
    a.out = (float*)d_out; a.ws = (unsigned char*)d_ws;
#if MK_MULTI
    for (int ph = 0; ph < NPH; ++ph) { a.ph_lo = ph; a.ph_hi = ph + 1; const int p = (ph < NL * NP) ? ph % NP : NP;
        switch (p) {
        case 0: launch_one<1u << 0>(grid, stream, a); break; case 1: launch_one<1u << 1>(grid, stream, a); break; case 2: launch_one<1u << 2>(grid, stream, a); break;
        case 3: launch_one<1u << 3>(grid, stream, a); break; case 4: launch_one<1u << 4>(grid, stream, a); break; case 5: break;
        case 6: launch_one<1u << 6>(grid, stream, a); break; case 7: launch_one<1u << 7>(grid, stream, a); break; case 8: launch_one<1u << 8>(grid, stream, a); break;
        case 9: launch_one<1u << 9>(grid, stream, a); break; case 10: launch_one<1u << 10>(grid, stream, a); break; case 11: launch_one<1u << 11>(grid, stream, a); break;
        case 12: launch_one<1u << 12>(grid, stream, a); break; default: launch_one<1u << 13>(grid, stream, a); break; } }
#else
    a.ph_lo = 0; a.ph_hi = NPH; launch_one<0xFFFFu>(grid, stream, a);
#endif
}
```
